# Optimizing an MI355X kernel written in HIP

```python
import jax, jax.numpy as jnp
from jax import lax
import numpy as np

D_MODEL = 2048
BATCH = 8
SEQ = 2048
DEPTH = 1

HEAD_DIM = 128
HEADS_PER_GROUP = 8
DILATED_GROUPS = ((128, 1), (512, 4), (2048, 16))
N_GROUPS = len(DILATED_GROUPS)
ATTN_WIDTH = N_GROUPS * HEADS_PER_GROUP * HEAD_DIM
ATTN_OUT_WIDTH = HEADS_PER_GROUP * HEAD_DIM
CONV_WIDTH = D_MODEL
CONV_K = 3
IN_COLS = 3 * ATTN_WIDTH + 3 * CONV_WIDTH + 2 * D_MODEL
FFN_HIDDEN = -(-(8 * D_MODEL) // (3 * 256)) * 256
ALPHA = (2 * DEPTH) ** 0.25
BETA = (8 * DEPTH) ** -0.25
LN_EPS = 1e-5

kernel_name = "hybrid_dilated_attn_shortconv_gated_deepnorm"


def layer_norm(x, g, b):
    xf = x.astype(jnp.float32)
    mu = xf.mean(-1, keepdims=True)
    var = jnp.square(xf - mu).mean(-1, keepdims=True)
    y = (xf - mu) * lax.rsqrt(var + LN_EPS) * g.astype(jnp.float32) + b.astype(jnp.float32)
    return y.astype(x.dtype)


def dilated_band_attention(q, k, v, window, dilation):
    b, s, h, dh = q.shape
    band = window // dilation
    length = s // dilation
    n_blk = -(-length // band)
    pad = n_blk * band - length

    def to_blocks(t):
        t = t.reshape(b, length, dilation, h, dh).transpose(0, 2, 3, 1, 4)
        t = jnp.pad(t, ((0, 0), (0, 0), (0, 0), (0, pad), (0, 0)))
        return t.reshape(b, dilation, h, n_blk, band, dh)

    def with_prev_block(t):
        prev = jnp.pad(t, ((0, 0), (0, 0), (0, 0), (1, 0), (0, 0), (0, 0)))[:, :, :, :-1]
        return jnp.concatenate([prev, t], axis=4)

    qb = to_blocks(q)
    kb = with_prev_block(to_blocks(k))
    vb = with_prev_block(to_blocks(v))

    scores = jnp.einsum('brhnqd,brhnkd->brhnqk', qb, kb).astype(jnp.float32) * (dh ** -0.5)
    qi = jnp.arange(band)[:, None]
    kj = jnp.arange(2 * band)[None, :]
    dist = band + qi - kj
    in_band = (dist >= 0) & (dist <= band)
    first_blk = (jnp.arange(n_blk) == 0)[:, None, None]
    valid = in_band[None] & ~(first_blk & (kj[None] < band))
    scores = jnp.where(valid, scores, -jnp.inf)
    m = scores.max(-1, keepdims=True)
    p = jnp.exp(scores - m)
    denom = p.sum(-1)
    o = jnp.einsum('brhnqk,brhnkd->brhnqd', p, vb.astype(jnp.float32)) / denom[..., None]
    lse = m[..., 0] + jnp.log(denom)

    o = o.reshape(b, dilation, h, n_blk * band, dh)[:, :, :, :length]
    o = o.transpose(0, 3, 1, 2, 4).reshape(b, s, h, dh)
    lse = lse.reshape(b, dilation, h, n_blk * band)[:, :, :, :length]
    lse = lse.transpose(0, 3, 1, 2).reshape(b, s, h)
    return o, lse


def causal_short_conv(z, w):
    s = z.shape[1]
    zp = jnp.pad(z, ((0, 0), (CONV_K - 1, 0), (0, 0)))
    y = w[0] * z
    for tap in range(1, CONV_K):
        y = y + w[tap] * zp[:, CONV_K - 1 - tap: CONV_K - 1 - tap + s]
    return y


def setup_inputs(seed: int = 0) -> dict:
    key = jax.random.key(seed)
    ks = jax.random.split(key, 16)
    f32 = jnp.float32
    d = D_MODEL

    def nrm(k, shape, scale):
        return jax.random.normal(k, shape, f32) * scale

    x = jax.random.normal(ks[0], (BATCH, SEQ, d), f32)
    w_qk = nrm(ks[1], (DEPTH, d, 2 * ATTN_WIDTH), d ** -0.5)
    w_v = nrm(ks[2], (DEPTH, d, ATTN_WIDTH), BETA * d ** -0.5)
    w_conv_in = nrm(ks[3], (DEPTH, d, 3 * CONV_WIDTH), d ** -0.5)
    w_gates = nrm(ks[4], (DEPTH, d, 2 * d), d ** -0.5)
    w_in = jnp.concatenate([w_qk, w_v, w_conv_in, w_gates], axis=-1)
    conv_w = nrm(ks[5], (DEPTH, CONV_K, CONV_WIDTH), CONV_K ** -0.5)
    w_attn_o = nrm(ks[6], (DEPTH, ATTN_OUT_WIDTH, d), BETA * ATTN_OUT_WIDTH ** -0.5)
    w_conv_o = nrm(ks[7], (DEPTH, CONV_WIDTH, d), BETA * CONV_WIDTH ** -0.5)
    w_out = nrm(ks[8], (DEPTH, d, d), BETA * d ** -0.5)
    ln1_g = 1.0 + nrm(ks[9], (DEPTH, d), 0.02)
    ln1_b = nrm(ks[10], (DEPTH, d), 0.02)
    w_ffn_gate = nrm(ks[11], (DEPTH, d, FFN_HIDDEN), d ** -0.5)
    w_ffn_up = nrm(ks[12], (DEPTH, d, FFN_HIDDEN), BETA * d ** -0.5)
    w_ffn_down = nrm(ks[13], (DEPTH, FFN_HIDDEN, d), BETA * FFN_HIDDEN ** -0.5)
    ln2_g = 1.0 + nrm(ks[14], (DEPTH, d), 0.02)
    ln2_b = nrm(ks[15], (DEPTH, d), 0.02)
    return {"x": x, "w_in": w_in, "conv_w": conv_w, "w_attn_o": w_attn_o,
            "w_conv_o": w_conv_o, "w_out": w_out, "ln1_g": ln1_g, "ln1_b": ln1_b,
            "w_ffn_gate": w_ffn_gate, "w_ffn_up": w_ffn_up, "w_ffn_down": w_ffn_down,
            "ln2_g": ln2_g, "ln2_b": ln2_b}


def reference(x, w_in, conv_w, w_attn_o, w_conv_o, w_out, ln1_g, ln1_b,
              w_ffn_gate, w_ffn_up, w_ffn_down, ln2_g, ln2_b):
    b, s, _ = x.shape
    cols = (ATTN_WIDTH,) * 3 + (CONV_WIDTH,) * 3 + (D_MODEL,) * 2
    split_points = [int(c) for c in np.cumsum(cols)[:-1]]
    for layer in range(DEPTH):
        proj = x @ w_in[layer]
        q, k, v, u, c_gate, b_gate, g_attn, g_conv = jnp.split(proj, split_points, axis=-1)

        q = q.reshape(b, s, N_GROUPS, HEADS_PER_GROUP, HEAD_DIM)
        k = k.reshape(b, s, N_GROUPS, HEADS_PER_GROUP, HEAD_DIM)
        v = v.reshape(b, s, N_GROUPS, HEADS_PER_GROUP, HEAD_DIM)
        outs, lses = [], []
        for g, (window, dilation) in enumerate(DILATED_GROUPS):
            o_g, lse_g = dilated_band_attention(q[:, :, g], k[:, :, g], v[:, :, g], window, dilation)
            outs.append(o_g)
            lses.append(lse_g)
        mix_w = jax.nn.softmax(jnp.stack(lses, axis=0), axis=0)
        attn = jnp.sum(mix_w[..., None] * jnp.stack(outs, axis=0), axis=0)
        attn = attn.reshape(b, s, ATTN_OUT_WIDTH).astype(x.dtype) @ w_attn_o[layer]

        conv = (b_gate * causal_short_conv(c_gate * u, conv_w[layer])) @ w_conv_o[layer]

        merged = (jax.nn.sigmoid(g_attn) * attn + jax.nn.sigmoid(g_conv) * conv) @ w_out[layer]
        x = layer_norm(ALPHA * x + merged, ln1_g[layer], ln1_b[layer])

        hidden = jax.nn.silu(x @ w_ffn_gate[layer]) * (x @ w_ffn_up[layer])
        x = layer_norm(ALPHA * x + hidden @ w_ffn_down[layer], ln2_g[layer], ln2_b[layer])
    return x
```

```cpp
#include <hip/hip_runtime.h>
#include <hip/hip_cooperative_groups.h>
#include <cstdio>
#include <cstdint>
namespace cg = cooperative_groups;
namespace pg8 {
#define PG8_LAS __attribute__((address_space(3)))
typedef unsigned short bf16_t;
typedef short bf16x8 __attribute__((ext_vector_type(8)));
typedef float f32x4 __attribute__((ext_vector_type(4)));
typedef unsigned u32x4 __attribute__((ext_vector_type(4)));
constexpr int BM = 256, BK = 64, HALF = 128, HTB = HALF * BK * 2  , STAGE_BYTES = 8 * HTB, NXCD = 8, WGM = 8;

__host__ __device__ __forceinline__ int lds_byte(int r, int c) { const int st = (r >> 4) * 2 + (c >> 5), rr = r & 15, cc = c & 31, ob = rr * 64 + cc * 2; return st * 1024 + (ob ^ (((ob >> 9) & 1) << 5)); }
__host__ __device__ __forceinline__ void stage_rc(int b, int& R, int& C) { const int st = b / 1024, sb = b % 1024, swz = sb ^ (((sb >> 9) & 1) << 5); R = (st >> 1) * 16 + swz / 64; C = (st & 1) * 32 + (swz % 64) / 2; }
__host__ __device__ __forceinline__ int perm32(int rho) { const int n = rho >> 4, i = rho & 15; return 8 * (i >> 2) + 4 * n + (i & 3); }

struct Unit { int pm, pn; };
struct Gemm { const bf16_t* A; const bf16_t* Bt; int M, N, K; };

struct StaticOrder {
    int nM, nN, nwg, G, c;
    __host__ __device__ void init(int M, int N, int G_, int c_) { nM = M / BM; nN = N / BM; nwg = nM * nN; G = G_; c = c_; }
    __host__ __device__ bool next(int i, Unit& u) const {
        const long L = (long)i * G + c; if (L >= nwg) return false;
        int wgid = (int)L; { const int q = nwg / NXCD, r = nwg % NXCD, xcd = wgid % NXCD, off = wgid / NXCD; wgid = (xcd < r ? xcd * (q + 1) : r * (q + 1) + (xcd - r) * q) + off; }
        const int nig = WGM * nN, gid = wgid / nig, fm = gid * WGM, gsz = (nM - fm) < WGM ? (nM - fm) : WGM;
        u.pm = fm + ((wgid % nig) % gsz); u.pn = (wgid % nig) / gsz; return true;
    }
    __device__ __forceinline__ void a_ready(const Unit&) const {}
    __device__ __forceinline__ void done(const Unit&) const {}
};

__device__ __forceinline__ unsigned cvt_pk_bf16(float lo, float hi) { unsigned r; asm volatile("v_cvt_pk_bf16_f32 %0, %1, %2" : "=v"(r) : "v"(lo), "v"(hi)); return r; }
__device__ __forceinline__ float sigmoid_f(float v) { return __builtin_amdgcn_rcpf(1.0f + __builtin_amdgcn_exp2f(-1.4426950408889634f * v)); }
__device__ __forceinline__ u32x4 pack8(const f32x4 a, const f32x4 b) { u32x4 w; w.x = cvt_pk_bf16(a[0], a[1]); w.y = cvt_pk_bf16(a[2], a[3]); w.z = cvt_pk_bf16(b[0], b[1]); w.w = cvt_pk_bf16(b[2], b[3]); return w; }
__device__ __forceinline__ void unpack8(const u32x4 w, f32x4& a, f32x4& b) {
    a[0] = __uint_as_float(w.x << 16); a[1] = __uint_as_float(w.x & 0xffff0000u); a[2] = __uint_as_float(w.y << 16); a[3] = __uint_as_float(w.y & 0xffff0000u);
    b[0] = __uint_as_float(w.z << 16); b[1] = __uint_as_float(w.z & 0xffff0000u); b[2] = __uint_as_float(w.w << 16); b[3] = __uint_as_float(w.w & 0xffff0000u); }

struct EpiInProj {
    static constexpr bool PERM = true, AFTER_DRAIN = false;
    bf16_t* QKV; bf16_t* Z; bf16_t* Bg; bf16_t* G; float qscale;
    __device__ __forceinline__ void operator()(const f32x4 (&acc)[2][2][4][2], const Unit& u, int wr, int wc, int fr, int fq) const {
        const int row0 = u.pm * BM + wr * 64 + fr, cl = wc * 32 + 8 * fq;
        if (u.pn < 36) {
            const float sc = (u.pn < 12) ? qscale : 1.0f;
#pragma unroll
            for (int ai = 0; ai < 2; ++ai)
#pragma unroll
                for (int m = 0; m < 4; ++m) { bf16_t* rowp = QKV + (size_t)(row0 + ai * HALF + m * 16) * 9216 + u.pn * BM + cl;
#pragma unroll
                    for (int bj = 0; bj < 2; ++bj) *(u32x4*)(rowp + bj * HALF) = pack8(acc[ai][bj][m][0] * sc, acc[ai][bj][m][1] * sc); }
        } else if (u.pn < 52) {
            const int cb = (u.pn - 36) * HALF + cl;
#pragma unroll
            for (int ai = 0; ai < 2; ++ai)
#pragma unroll
                for (int m = 0; m < 4; ++m) *(u32x4*)(Z + (size_t)(row0 + ai * HALF + m * 16) * 2048 + cb) = pack8(acc[ai][0][m][0] * acc[ai][1][m][0], acc[ai][0][m][1] * acc[ai][1][m][1]);
        } else if (u.pn < 60) {
            const int cb = (u.pn - 52) * BM + cl;
#pragma unroll
            for (int ai = 0; ai < 2; ++ai)
#pragma unroll
                for (int m = 0; m < 4; ++m) { bf16_t* rowp = Bg + (size_t)(row0 + ai * HALF + m * 16) * 2048 + cb;
#pragma unroll
                    for (int bj = 0; bj < 2; ++bj) *(u32x4*)(rowp + bj * HALF) = pack8(acc[ai][bj][m][0], acc[ai][bj][m][1]); }
        } else {
            const int cb = (u.pn - 60) * BM + cl;
#pragma unroll
            for (int ai = 0; ai < 2; ++ai)
#pragma unroll
                for (int m = 0; m < 4; ++m) { bf16_t* rowp = G + (size_t)(row0 + ai * HALF + m * 16) * 4096 + cb;
#pragma unroll
                    for (int bj = 0; bj < 2; ++bj) { f32x4 a = acc[ai][bj][m][0], b = acc[ai][bj][m][1];
#pragma unroll
                        for (int e = 0; e < 4; ++e) { a[e] = sigmoid_f(a[e]); b[e] = sigmoid_f(b[e]); }
                        *(u32x4*)(rowp + bj * HALF) = pack8(a, b); } }
        }
    }
};
struct EpiGateMul {
    static constexpr bool PERM = true, AFTER_DRAIN = false;
    const bf16_t* G; int ldg; bf16_t* T;
    __device__ __forceinline__ void operator()(const f32x4 (&acc)[2][2][4][2], const Unit& u, int wr, int wc, int fr, int fq) const {
        const int row0 = u.pm * BM + wr * 64 + fr, col0 = u.pn * BM + wc * 32 + 8 * fq;
#pragma unroll
        for (int ai = 0; ai < 2; ++ai)
#pragma unroll
            for (int m = 0; m < 4; ++m) { const size_t r = (size_t)(row0 + ai * HALF + m * 16);
#pragma unroll
                for (int bj = 0; bj < 2; ++bj) { f32x4 ga, gb; unpack8(*(const u32x4*)(G + r * ldg + col0 + bj * HALF), ga, gb);
                    *(u32x4*)(T + r * 2048 + col0 + bj * HALF) = pack8(acc[ai][bj][m][0] * ga, acc[ai][bj][m][1] * gb); } }
    }
};
struct EpiGateMulAdd {
    static constexpr bool PERM = true, AFTER_DRAIN = false;
    const bf16_t* G; int ldg; const bf16_t* T; bf16_t* O;
    __device__ __forceinline__ void operator()(const f32x4 (&acc)[2][2][4][2], const Unit& u, int wr, int wc, int fr, int fq) const {
        const int row0 = u.pm * BM + wr * 64 + fr, col0 = u.pn * BM + wc * 32 + 8 * fq;
#pragma unroll
        for (int ai = 0; ai < 2; ++ai)
#pragma unroll
            for (int m = 0; m < 4; ++m) { const size_t r = (size_t)(row0 + ai * HALF + m * 16);
#pragma unroll
                for (int bj = 0; bj < 2; ++bj) { f32x4 ga, gb, ta, tb; unpack8(*(const u32x4*)(G + r * ldg + col0 + bj * HALF), ga, gb); unpack8(*(const u32x4*)(T + r * 2048 + col0 + bj * HALF), ta, tb);
                    *(u32x4*)(O + r * 2048 + col0 + bj * HALF) = pack8(ta + acc[ai][bj][m][0] * ga, tb + acc[ai][bj][m][1] * gb); } }
    }
};
struct EpiResF32 {
    static constexpr bool PERM = false, AFTER_DRAIN = false;
    const float* base; float* out; float alpha;
    __device__ __forceinline__ void operator()(const f32x4 (&acc)[2][2][4][2], const Unit& u, int wr, int wc, int fr, int fq) const {
        const int row0 = u.pm * BM + wr * 64 + fr, col0 = u.pn * BM + wc * 32 + 4 * fq;
#pragma unroll
        for (int ai = 0; ai < 2; ++ai)
#pragma unroll
            for (int m = 0; m < 4; ++m) { const size_t off = (size_t)(row0 + ai * HALF + m * 16) * 2048 + col0;
#pragma unroll
                for (int bj = 0; bj < 2; ++bj)
#pragma unroll
                    for (int n = 0; n < 2; ++n) { const f32x4 bs = *(const f32x4*)(base + off + bj * HALF + n * 16); *(f32x4*)(out + off + bj * HALF + n * 16) = bs * alpha + acc[ai][bj][m][n]; } }
    }
};
struct EpiSwiGlu {
    static constexpr bool PERM = true, AFTER_DRAIN = false;
    bf16_t* H;
    __device__ __forceinline__ void operator()(const f32x4 (&acc)[2][2][4][2], const Unit& u, int wr, int wc, int fr, int fq) const {
        const int row0 = u.pm * BM + wr * 64 + fr, cb = u.pn * HALF + wc * 32 + 8 * fq;
#pragma unroll
        for (int ai = 0; ai < 2; ++ai)
#pragma unroll
            for (int m = 0; m < 4; ++m) { f32x4 a = acc[ai][0][m][0], b = acc[ai][0][m][1];
#pragma unroll
                for (int e = 0; e < 4; ++e) { a[e] = a[e] * sigmoid_f(a[e]); b[e] = b[e] * sigmoid_f(b[e]); }
                *(u32x4*)(H + (size_t)(row0 + ai * HALF + m * 16) * 5632 + cb) = pack8(a * acc[ai][1][m][0], b * acc[ai][1][m][1]); }
    }
};
template <class Epi, class Sched, bool ALIGN_EPI = false, bool SP2 = false>
__device__ __forceinline__ void gemm_phase(PG8_LAS unsigned char* lds, const Gemm g, const Sched& S, const Epi& E) {
    const int tid = threadIdx.x, wid = __builtin_amdgcn_readfirstlane(tid >> 6), lane = tid & 63, wr = wid >> 2, wc = wid & 3, fr = lane & 15, fq = lane >> 4;
    const int K = g.K, nt = K / BK;
    unsigned voffA[2], voffB[2];
#pragma unroll
    for (int i = 0; i < 2; ++i) { int R, C; stage_rc(tid * 16 + i * 8192, R, C); const int Rb = Epi::PERM ? ((R & ~31) + perm32(R & 31)) : R;
        voffA[i] = (unsigned)(R * K + C) * 2u; voffB[i] = (unsigned)(Rb * K + C) * 2u; }
    const size_t kstep = (size_t)(BK * 2);
    const size_t hstep = (size_t)HALF * K * 2;
    const size_t tstep = 2 * hstep;
    const unsigned ldsw = (unsigned)wid * 1024u;
    const int aoff = lds_byte(wr * 64 + fr, fq * 8), boff = lds_byte(wc * 32 + fr, fq * 8);
#define PG8_SA(b, h) (((b) * 2 + (h)) * HTB)
#define PG8_SB(b, h) ((4 + (b) * 2 + (h)) * HTB)
#define PG8_STAGE(bufoff, gbase, voff) do { _Pragma("unroll") for (int _i = 0; _i < 2; ++_i) \
        __builtin_amdgcn_global_load_lds((const unsigned*)((const char*)(gbase) + (voff)[_i]), (PG8_LAS unsigned*)(lds + (bufoff) + ldsw + _i * 8192), 16, 0, 0); } while (0)
#define PG8_LDA(dst, b, h) do { _Pragma("unroll") for (int m = 0; m < 4; ++m) _Pragma("unroll") for (int k = 0; k < 2; ++k) dst[m][k] = *(const PG8_LAS bf16x8*)(lds + PG8_SA(b, h) + aoff + m * 2048 + k * 1024); } while (0)
#define PG8_LDB(dst, b, h) do { _Pragma("unroll") for (int n = 0; n < 2; ++n) _Pragma("unroll") for (int k = 0; k < 2; ++k) dst[n][k] = *(const PG8_LAS bf16x8*)(lds + PG8_SB(b, h) + boff + n * 2048 + k * 1024); } while (0)
#define PG8_MMA(ai, bj, At, Bt) do { __builtin_amdgcn_s_setprio(1); _Pragma("unroll") for (int m = 0; m < 4; ++m) _Pragma("unroll") for (int n = 0; n < 2; ++n) _Pragma("unroll") for (int k = 0; k < 2; ++k) \
        acc[ai][bj][m][n] = __builtin_amdgcn_mfma_f32_16x16x32_bf16(Bt[n][k], At[m][k], acc[ai][bj][m][n], 0, 0, 0); __builtin_amdgcn_s_setprio(0); } while (0)
#define PG8_WAIT_V(n) asm volatile("s_waitcnt vmcnt(" #n ")" ::: "memory")
#define PG8_WAIT_L(n) asm volatile("s_waitcnt lgkmcnt(" #n ")" ::: "memory")
#define PG8_BAR __builtin_amdgcn_s_barrier()
#define PG8_SCHED __builtin_amdgcn_sched_barrier(0)
    Unit cur, nxt; int ui = 0;
    if (!S.next(0, cur)) return;
    f32x4 acc[2][2][4][2];
#pragma unroll
    for (int a = 0; a < 2; ++a)
#pragma unroll
        for (int b = 0; b < 2; ++b)
#pragma unroll
            for (int m = 0; m < 4; ++m)
#pragma unroll
                for (int n = 0; n < 2; ++n) acc[a][b][m][n] = (f32x4){0.f, 0.f, 0.f, 0.f};
    bf16x8 At[4][2], B0[2][2], B1[2][2];
    const char* cA = (const char*)g.A + (size_t)cur.pm * tstep; const char* cB = (const char*)g.Bt + (size_t)cur.pn * tstep;
    S.a_ready(cur);
    if constexpr (SP2) {
        PG8_STAGE(PG8_SB(0, 0), cB, voffB); PG8_STAGE(PG8_SB(0, 1), cB + hstep, voffB); PG8_STAGE(PG8_SA(0, 0), cA, voffA); PG8_STAGE(PG8_SA(0, 1), cA + hstep, voffA);
        if (wr == 1) PG8_BAR;
        PG8_WAIT_V(2); PG8_BAR;
        PG8_STAGE(PG8_SB(1, 0), cB + kstep, voffB); PG8_STAGE(PG8_SA(1, 0), cA + kstep, voffA); PG8_STAGE(PG8_SB(1, 1), cB + hstep + kstep, voffB);
        PG8_WAIT_V(6); PG8_BAR;
    } else {
        PG8_STAGE(PG8_SB(0, 0), cB, voffB); PG8_STAGE(PG8_SA(0, 0), cA, voffA); PG8_STAGE(PG8_SB(0, 1), cB + hstep, voffB); PG8_STAGE(PG8_SA(0, 1), cA + hstep, voffA);
        if (wr == 1) PG8_BAR;
        PG8_WAIT_V(4); PG8_BAR;
        PG8_STAGE(PG8_SB(1, 0), cB + kstep, voffB); PG8_STAGE(PG8_SA(1, 0), cA + kstep, voffA); PG8_STAGE(PG8_SB(1, 1), cB + hstep + kstep, voffB);
        PG8_WAIT_V(6); PG8_BAR;
    }
    for (;;) {
        const bool has_next = S.next(ui + 1, nxt);
        const char* nA = has_next ? (const char*)g.A + (size_t)nxt.pm * tstep : cA; const char* nB = has_next ? (const char*)g.Bt + (size_t)nxt.pn * tstep : cB;
        for (int t = 0; t < nt; t += 2) {
            const bool last = (t == nt - 2);
            const char* a1 = cA + (size_t)(t + 1) * kstep;
            const char* a2 = last ? nA : cA + (size_t)(t + 2) * kstep; const char* b2 = last ? nB : cB + (size_t)(t + 2) * kstep;
            const char* a3 = a2 + kstep; const char* b3 = b2 + kstep;
            if (last && has_next) S.a_ready(nxt);
            if constexpr (SP2) {
            PG8_LDB(B0, 0, 0); PG8_LDB(B1, 0, 1); PG8_SCHED; PG8_LDA(At, 0, 0); PG8_STAGE(PG8_SA(1, 1), a1 + hstep, voffA);
            PG8_WAIT_V(8); PG8_WAIT_L(0); PG8_BAR; PG8_MMA(0, 0, At, B0); PG8_MMA(0, 1, At, B1); PG8_BAR; PG8_SCHED;
            PG8_LDA(At, 0, 1); PG8_STAGE(PG8_SB(0, 0), b2, voffB); PG8_STAGE(PG8_SB(0, 1), b2 + hstep, voffB); PG8_STAGE(PG8_SA(0, 0), a2, voffA);
            PG8_WAIT_V(8); PG8_WAIT_L(0); PG8_BAR; PG8_MMA(1, 0, At, B0); PG8_MMA(1, 1, At, B1); PG8_BAR; PG8_SCHED;
            PG8_LDB(B0, 1, 0); PG8_LDB(B1, 1, 1); PG8_SCHED; PG8_LDA(At, 1, 0); PG8_STAGE(PG8_SA(0, 1), a2 + hstep, voffA);
            PG8_WAIT_V(8); PG8_WAIT_L(0); PG8_BAR; PG8_MMA(0, 0, At, B0); PG8_MMA(0, 1, At, B1); PG8_BAR; PG8_SCHED;
            PG8_LDA(At, 1, 1); PG8_STAGE(PG8_SB(1, 0), b3, voffB); PG8_STAGE(PG8_SB(1, 1), b3 + hstep, voffB); PG8_STAGE(PG8_SA(1, 0), a3, voffA);
            PG8_WAIT_V(8); PG8_WAIT_L(0); PG8_BAR; PG8_MMA(1, 0, At, B0); PG8_MMA(1, 1, At, B1); PG8_BAR; PG8_SCHED;
            } else {
            PG8_LDB(B0, 0, 0); PG8_SCHED; PG8_LDA(At, 0, 0); PG8_STAGE(PG8_SA(1, 1), a1 + hstep, voffA);
            PG8_WAIT_L(8); PG8_BAR; PG8_WAIT_L(0); PG8_MMA(0, 0, At, B0); PG8_BAR; PG8_SCHED;
            PG8_LDB(B1, 0, 1); PG8_STAGE(PG8_SB(0, 0), b2, voffB);
            PG8_BAR; PG8_WAIT_L(0); PG8_MMA(0, 1, At, B1); PG8_BAR;
            PG8_LDA(At, 0, 1); PG8_STAGE(PG8_SA(0, 0), a2, voffA);
            PG8_BAR; PG8_WAIT_L(0); PG8_MMA(1, 0, At, B0); PG8_BAR; PG8_SCHED;
            PG8_STAGE(PG8_SB(0, 1), b2 + hstep, voffB);
            PG8_WAIT_V(6); PG8_BAR; PG8_MMA(1, 1, At, B1); PG8_BAR;
            PG8_LDB(B0, 1, 0); PG8_SCHED; PG8_LDA(At, 1, 0); PG8_STAGE(PG8_SA(0, 1), a2 + hstep, voffA);
            PG8_WAIT_L(8); PG8_BAR; PG8_WAIT_L(0); PG8_MMA(0, 0, At, B0); PG8_BAR; PG8_SCHED;
            PG8_LDB(B1, 1, 1); PG8_STAGE(PG8_SB(1, 0), b3, voffB);
            PG8_BAR; PG8_WAIT_L(0); PG8_MMA(0, 1, At, B1); PG8_BAR;
            PG8_LDA(At, 1, 1); PG8_STAGE(PG8_SA(1, 0), a3, voffA);
            PG8_BAR; PG8_WAIT_L(0); PG8_MMA(1, 0, At, B0); PG8_BAR; PG8_SCHED;
            PG8_STAGE(PG8_SB(1, 1), b3 + hstep, voffB);
            PG8_WAIT_V(6); PG8_BAR; PG8_MMA(1, 1, At, B1); PG8_BAR;
            }
        }
        if constexpr (ALIGN_EPI) { if (wr == 0) PG8_BAR; }
        if constexpr (!Epi::AFTER_DRAIN) { E(acc, cur, wr, wc, fr, fq); S.done(cur); }
        if (!has_next) break;
#pragma unroll
        for (int a = 0; a < 2; ++a)
#pragma unroll
            for (int b = 0; b < 2; ++b)
#pragma unroll
                for (int m = 0; m < 4; ++m)
#pragma unroll
                    for (int n = 0; n < 2; ++n) acc[a][b][m][n] = (f32x4){0.f, 0.f, 0.f, 0.f};
        cur = nxt; cA = nA; cB = nB; ++ui;
        if constexpr (ALIGN_EPI) { if (wr == 1) PG8_BAR; }
    }
    PG8_WAIT_V(0);
    if constexpr (!ALIGN_EPI) { if (wr == 0) PG8_BAR; }
    PG8_BAR;
    if constexpr (Epi::AFTER_DRAIN) { E.fused(acc, cur, wr, wc, fr, fq, lds, wid, lane); S.done(cur); }
#undef PG8_SA
#undef PG8_SB
#undef PG8_STAGE
#undef PG8_LDA
#undef PG8_LDB
#undef PG8_MMA
#undef PG8_WAIT_V
#undef PG8_WAIT_L
#undef PG8_BAR
#undef PG8_SCHED
}
}
constexpr int BATCH = 8, SEQ = 2048, DM = 2048, M = BATCH * SEQ;
constexpr int INC = 19456, QKVW = 9216, FFN = 5632, AOW = 1024;
constexpr float LN_EPS = 1e-5f, ALPHA = 1.189207115002721f;
constexpr float QSCALE = 0.08838834764831845f * 1.4426950408889634f;
constexpr size_t MiB = 1u << 20;
constexpr size_t WS_WAO = 1 * MiB, WS_WCO = 5 * MiB, WS_WOUT = 13 * MiB;
constexpr size_t WS_WIN = 21 * MiB;
constexpr size_t WS_XB = 97 * MiB;
constexpr size_t WS_QKV = 161 * MiB;
constexpr size_t WS_Z = 449 * MiB;
constexpr size_t WS_BG = 513 * MiB;
constexpr size_t WS_PO = 21 * MiB;
constexpr size_t WS_LSE = 117 * MiB;
constexpr size_t WS_AH = 119 * MiB;
constexpr size_t WS_T = 161 * MiB, WS_MG = 225 * MiB;
constexpr size_t WS_WGU = 289 * MiB, WS_WDN = 333 * MiB;
constexpr size_t WS_X1B = 355 * MiB;
constexpr size_t WS_H = 21 * MiB;
constexpr size_t WS_NEED = 608 * MiB;
constexpr int LDS_BYTES = 147456, NWAVES = 8;

#define LAS __attribute__((address_space(3)))
typedef pg8::bf16_t bf16_t;
typedef pg8::f32x4 f32x4;
typedef pg8::u32x4 u32x4;
typedef pg8::bf16x8 bf16x8;
typedef float f32x16 __attribute__((ext_vector_type(16)));
typedef short s16x4 __attribute__((ext_vector_type(4)));
using pg8::cvt_pk_bf16;

struct Args { const float* in[13]; float* out; unsigned char* ws; };

__device__ __forceinline__ float wave_sum(float v) {
#pragma unroll
    for (int o = 1; o < 64; o <<= 1) v += __shfl_xor(v, o);
    return v;
}
__device__ __forceinline__ void tr_item(const float* __restrict__ src, int ldn, int c0, int k0, bf16_t* __restrict__ dst, int K, int r0, LAS float* scr, int lane) {
    f32x4 v[16];
#pragma unroll
    for (int i = 0; i < 16; ++i) v[i] = *(const f32x4*)(src + (size_t)(k0 + 4 * i + (lane >> 4)) * ldn + c0 + (lane & 15) * 4);
#pragma unroll
    for (int i = 0; i < 16; ++i) { LAS float* p = scr + (4 * i + (lane >> 4)) * 65 + (lane & 15) * 4; p[0] = v[i][0]; p[1] = v[i][1]; p[2] = v[i][2]; p[3] = v[i][3]; }
    asm volatile("s_waitcnt lgkmcnt(0)" ::: "memory");
    const int c = lane & 7;
#pragma unroll
    for (int j = 0; j < 8; ++j) { const int n = (lane >> 3) + 8 * j; const LAS float* s = scr + (8 * c) * 65 + n;
        u32x4 o; o.x = cvt_pk_bf16(s[0], s[65]); o.y = cvt_pk_bf16(s[130], s[195]); o.z = cvt_pk_bf16(s[260], s[325]); o.w = cvt_pk_bf16(s[390], s[455]);
        *(u32x4*)(dst + (size_t)(r0 + n) * K + k0 + 8 * c) = o; }
    asm volatile("s_waitcnt lgkmcnt(0)" ::: "memory");
}
__device__ __forceinline__ void p0_weights(const Args& a, unsigned char* ws, LAS float* scr, int gw, int ngw, int lane) {
    constexpr int I_IN = 304 * 32, I_AO = 32 * 16, I_CO = 32 * 32, I_OUT = 32 * 32;
    for (int it = gw; it < I_IN + I_AO + I_CO + I_OUT; it += ngw) {
        int r = it;
        if (r < I_IN) { const int kb = r / 304, rb = r % 304; int c0 = 64 * rb;
            if (rb >= 144 && rb < 208) { const int q = rb - 144; c0 = 9216 + ((q & 3) >> 1) * 2048 + 128 * (q >> 2) + 64 * (q & 1); }
            tr_item(a.in[1], INC, c0, 64 * kb, (bf16_t*)(ws + WS_WIN), 2048, 64 * rb, scr, lane); continue; } r -= I_IN;
        if (r < I_AO) { tr_item(a.in[3], 2048, 64 * (r % 32), 64 * (r / 32), (bf16_t*)(ws + WS_WAO), 1024, 64 * (r % 32), scr, lane); continue; } r -= I_AO;
        if (r < I_CO) { tr_item(a.in[4], 2048, 64 * (r % 32), 64 * (r / 32), (bf16_t*)(ws + WS_WCO), 2048, 64 * (r % 32), scr, lane); continue; } r -= I_CO;
        tr_item(a.in[5], 2048, 64 * (r % 32), 64 * (r / 32), (bf16_t*)(ws + WS_WOUT), 2048, 64 * (r % 32), scr, lane);
    }
}
__device__ __forceinline__ void p3_weights(const Args& a, unsigned char* ws, LAS float* scr, int gw, int ngw, int lane) {
    constexpr int I_GU = 176 * 32, I_DN = 32 * 88;
    for (int it = gw; it < I_GU + I_DN; it += ngw) {
        int r = it;
        if (r < I_GU) { const int kb = r / 176, rb = r % 176; const int c0 = 128 * (rb >> 2) + 64 * (rb & 1);
            tr_item(((rb & 3) >> 1) ? a.in[9] : a.in[8], FFN, c0, 64 * kb, (bf16_t*)(ws + WS_WGU), 2048, 64 * rb, scr, lane); continue; } r -= I_GU;
        tr_item(a.in[10], 2048, 64 * (r % 32), 64 * (r / 32), (bf16_t*)(ws + WS_WDN), FFN, 64 * (r % 32), scr, lane);
    }
}
__device__ __forceinline__ void ln_rows(float* Y, const float* __restrict__ g, const float* __restrict__ bt, bf16_t* ob, int gw, int ngw, int lane) {
    for (int row = gw; row < M; row += ngw) {
        f32x4* yr = (f32x4*)(Y + (size_t)row * DM) + lane;
        f32x4 v[8]; float s = 0.f;
#pragma unroll
        for (int j = 0; j < 8; ++j) { v[j] = yr[64 * j]; s += (v[j][0] + v[j][1]) + (v[j][2] + v[j][3]); }
        const float mean = wave_sum(s) * (1.0f / DM); float s2 = 0.f;
#pragma unroll
        for (int j = 0; j < 8; ++j) { v[j] = v[j] - mean; s2 += (v[j][0] * v[j][0] + v[j][1] * v[j][1]) + (v[j][2] * v[j][2] + v[j][3] * v[j][3]); }
        const float rstd = 1.0f / sqrtf(wave_sum(s2) * (1.0f / DM) + LN_EPS);
#pragma unroll
        for (int j = 0; j < 8; ++j) { const f32x4 gg = ((const f32x4*)g)[lane + 64 * j], bb = ((const f32x4*)bt)[lane + 64 * j]; const f32x4 o = v[j] * rstd * gg + bb;
            yr[64 * j] = o;
            if (ob) { unsigned long long w = (unsigned long long)cvt_pk_bf16(o[0], o[1]) | ((unsigned long long)cvt_pk_bf16(o[2], o[3]) << 32); ((unsigned long long*)(ob + (size_t)row * DM))[lane + 64 * j] = w; } }
    }
}
__device__ __forceinline__ int crow(int r, int hi) { return (r & 3) + 8 * (r >> 2) + 4 * hi; }
__device__ __forceinline__ s16x4 vtr(LAS const unsigned char* p) { return __builtin_bit_cast(s16x4, __builtin_amdgcn_ds_read_tr16_b64_v4i16((LAS s16x4*)p)); }
__device__ __forceinline__ void glds16(const void* gsrc, unsigned lds_dst) { unsigned keep;
    asm volatile("s_mov_b32 %0, m0\n\ts_mov_b32 m0, %2\n\ts_nop 0\n\tglobal_load_lds_dwordx4 %1, off\n\ts_mov_b32 m0, %0" : "=&s"(keep) : "v"(gsrc), "s"(lds_dst) : "memory"); }
__device__ __forceinline__ void attn_qtile(const bf16_t* __restrict__ QKV, bf16_t* __restrict__ PO, float* __restrict__ LSE, int b, int h, int g, int res, int dil, int i0, LAS unsigned char* vlds, int lane) {
    const int x = lane & 31, hi = lane >> 5;
    const size_t rowbase = (size_t)b * SEQ;
    const int colq = g * 1024 + h * 128;
    bf16x8 qf[8];
    { const bf16_t* qp = QKV + (rowbase + res + (size_t)dil * (i0 + x)) * QKVW + colq + 8 * hi;
#pragma unroll
      for (int d0 = 0; d0 < 8; ++d0) qf[d0] = *(const bf16x8*)(qp + 16 * d0); }
    const int kt1 = i0 >> 5, kt0 = kt1 > 4 ? kt1 - 4 : 0;
    const bf16_t* kbase = QKV + (rowbase + res) * QKVW + 3072 + colq + 8 * hi;
    const int vr = lane >> 4, vcb = (lane & 15) ^ (vr << 2);
    const bf16_t* vbase = QKV + (rowbase + res) * QKVW + 6144 + colq;
    const unsigned vl0 = (unsigned)(uintptr_t)vlds;
    const int q4 = (lane & 15) >> 2, p4 = lane & 3, blk = (lane >> 4) & 1;
    int tra[4][2];
#pragma unroll
    for (int c = 0; c < 4; ++c)
#pragma unroll
        for (int t = 0; t < 2; ++t) { const int row = 8 * t + 4 * hi + q4, ch = 4 * c + 2 * blk + (p4 >> 1);
            tra[c][t] = 256 * row + 16 * (ch ^ (((row & 3) << 2) | ((row >> 2) & 3))) + 8 * (p4 & 1); }
    bf16x8 kn[8];
#define ATT_LOAD(kt, buf) do { const size_t tk_ = (size_t)dil * (32 * (kt) + x) * QKVW; \
        _Pragma("unroll") for (int d0 = 0; d0 < 8; ++d0) kn[d0] = *(const bf16x8*)(kbase + tk_ + 16 * d0); \
        _Pragma("unroll") for (int i = 0; i < 8; ++i) glds16(vbase + (size_t)dil * (32 * (kt) + vr + 4 * i) * QKVW + 8 * (vcb ^ (i & 3)), (unsigned)__builtin_amdgcn_readfirstlane(vl0 + (buf) * 8192 + 1024 * i)); } while (0)
    ATT_LOAD(kt0, 0);
    f32x16 o[4];
#pragma unroll
    for (int c = 0; c < 4; ++c) o[c] = f32x16{};
    float mrun = -INFINITY, lrun = 0.f;
    int cur = 0;
    for (int kt = kt0; kt <= kt1; ++kt) {
        asm volatile("s_waitcnt vmcnt(0)" ::: "memory");
        f32x16 s = f32x16{};
#pragma unroll
        for (int d0 = 0; d0 < 8; ++d0) s = __builtin_amdgcn_mfma_f32_32x32x16_bf16(kn[d0], qf[d0], s, 0, 0, 0);
        if (kt < kt1) ATT_LOAD(kt + 1, cur ^ 1);
        const int dj = 32 * kt - i0 - x;
        float mx = -INFINITY;
#pragma unroll
        for (int r = 0; r < 16; ++r) { const int d = dj + crow(r, hi); s[r] = (d <= 0 && d >= -128) ? s[r] : -INFINITY; mx = fmaxf(mx, s[r]); }
        mx = fmaxf(mx, __shfl_xor(mx, 32));
        const float mnew = fmaxf(mrun, mx), alpha = __builtin_amdgcn_exp2f(mrun - mnew);
        float rs = 0.f;
#pragma unroll
        for (int r = 0; r < 16; ++r) { s[r] = __builtin_amdgcn_exp2f(s[r] - mnew); rs += s[r]; }
        rs += __shfl_xor(rs, 32);
        lrun = lrun * alpha + rs; mrun = mnew;
#pragma unroll
        for (int c = 0; c < 4; ++c)
#pragma unroll
            for (int r = 0; r < 16; ++r) o[c][r] *= alpha;
        bf16x8 pb[2];
#pragma unroll
        for (int j = 0; j < 2; ++j) { u32x4 w; w.x = cvt_pk_bf16(s[8 * j], s[8 * j + 1]); w.y = cvt_pk_bf16(s[8 * j + 2], s[8 * j + 3]); w.z = cvt_pk_bf16(s[8 * j + 4], s[8 * j + 5]); w.w = cvt_pk_bf16(s[8 * j + 6], s[8 * j + 7]); pb[j] = __builtin_bit_cast(bf16x8, w); }
        LAS const unsigned char* vb = vlds + cur * 8192;
#pragma unroll
        for (int c = 0; c < 4; ++c)
#pragma unroll
            for (int j = 0; j < 2; ++j) { const s16x4 lo = vtr(vb + tra[c][0] + 4096 * j), hi4 = vtr(vb + tra[c][1] + 4096 * j);
                const bf16x8 vf = (bf16x8){lo[0], lo[1], lo[2], lo[3], hi4[0], hi4[1], hi4[2], hi4[3]};
                o[c] = __builtin_amdgcn_mfma_f32_32x32x16_bf16(vf, pb[j], o[c], 0, 0, 0); }
        cur ^= 1;
    }
#undef ATT_LOAD
    const float inv = 1.0f / lrun;
    const size_t row = rowbase + res + (size_t)dil * (i0 + x);
    bf16_t* po = PO + ((size_t)g * M + row) * 1024 + h * 128 + 4 * hi;
#pragma unroll
    for (int c = 0; c < 4; ++c)
#pragma unroll
        for (int rr = 0; rr < 4; ++rr) { unsigned long long w = (unsigned long long)cvt_pk_bf16(o[c][4 * rr] * inv, o[c][4 * rr + 1] * inv) | ((unsigned long long)cvt_pk_bf16(o[c][4 * rr + 2] * inv, o[c][4 * rr + 3] * inv) << 32);
            *(unsigned long long*)(po + 32 * c + 8 * rr) = w; }
    if (hi == 0) LSE[((size_t)g * M + row) * 8 + h] = mrun + __builtin_amdgcn_logf(lrun);
}
__device__ __forceinline__ void attn_phase(unsigned char* ws, LAS unsigned char* lds, int nblk, int bid, int tid, int wave, int lane) {
    const bf16_t* QKV = (const bf16_t*)(ws + WS_QKV); bf16_t* PO = (bf16_t*)(ws + WS_PO); float* LSE = (float*)(ws + WS_LSE); bf16_t* AH = (bf16_t*)(ws + WS_AH);
    LAS unsigned char* vlds = lds + wave * 16384;
    for (int su = bid; su < BATCH * 8 * 4; su += nblk) {
        const int b = su >> 5, h = (su >> 2) & 7, blk = su & 3;
        for (int j = 0; j < 6; ++j) {
            const int qi = wave + 8 * j;
            int g, res, dil, i0;
            if (qi < 16) { g = 0; res = 0; dil = 1; i0 = 512 * blk + 32 * qi; }
            else if (qi < 32) { g = 1; res = (qi - 16) >> 2; dil = 4; i0 = 128 * blk + 32 * ((qi - 16) & 3); }
            else { g = 2; res = qi - 32; dil = 16; i0 = 32 * blk; }
            attn_qtile(QKV, PO, LSE, b, h, g, res, dil, i0, vlds, lane);
        }
        __syncthreads();
        for (int it = 0; it < 16; ++it) {
            const int task = tid + 512 * it, tl = task >> 4, ch = task & 15;
            const size_t row = (size_t)b * SEQ + 512 * blk + tl;
            const float l0 = LSE[row * 8 + h], l1 = LSE[((size_t)M + row) * 8 + h], l2 = LSE[((size_t)2 * M + row) * 8 + h];
            const float mx = fmaxf(l0, fmaxf(l1, l2));
            float w0 = __builtin_amdgcn_exp2f(l0 - mx), w1 = __builtin_amdgcn_exp2f(l1 - mx), w2 = __builtin_amdgcn_exp2f(l2 - mx);
            const float inv = 1.0f / (w0 + w1 + w2); w0 *= inv; w1 *= inv; w2 *= inv;
            f32x4 a0, b0, a1, b1, a2, b2;
            pg8::unpack8(*(const u32x4*)(PO + row * 1024 + h * 128 + ch * 8), a0, b0);
            pg8::unpack8(*(const u32x4*)(PO + ((size_t)M + row) * 1024 + h * 128 + ch * 8), a1, b1);
            pg8::unpack8(*(const u32x4*)(PO + ((size_t)2 * M + row) * 1024 + h * 128 + ch * 8), a2, b2);
            *(u32x4*)(AH + row * 1024 + h * 128 + ch * 8) = pg8::pack8(a0 * w0 + a1 * w1 + a2 * w2, b0 * w0 + b1 * w1 + b2 * w2);
        }
        __syncthreads();
    }
}
__device__ __forceinline__ void conv_phase(const float* __restrict__ cw, unsigned char* ws, int gt, int ngt) {
    const bf16_t* Z = (const bf16_t*)(ws + WS_Z); bf16_t* Bg = (bf16_t*)(ws + WS_BG);
    for (int task = gt; task < (M / 8) * 256; task += ngt) {
        const int ch = task & 255, tb = task >> 8; const int t0 = tb * 8; const int c8 = ch * 8;
        f32x4 w0a = *(const f32x4*)(cw + c8), w0b = *(const f32x4*)(cw + c8 + 4), w1a = *(const f32x4*)(cw + 2048 + c8), w1b = *(const f32x4*)(cw + 2048 + c8 + 4), w2a = *(const f32x4*)(cw + 4096 + c8), w2b = *(const f32x4*)(cw + 4096 + c8 + 4);
        f32x4 zm2a = {0.f, 0.f, 0.f, 0.f}, zm2b = zm2a, zm1a = zm2a, zm1b = zm2a;
        if ((t0 & (SEQ - 1)) != 0) { pg8::unpack8(*(const u32x4*)(Z + (size_t)(t0 - 2) * 2048 + c8), zm2a, zm2b); pg8::unpack8(*(const u32x4*)(Z + (size_t)(t0 - 1) * 2048 + c8), zm1a, zm1b); }
#pragma unroll
        for (int i = 0; i < 8; ++i) { const size_t off = (size_t)(t0 + i) * 2048 + c8;
            f32x4 za, zb, ba, bb; pg8::unpack8(*(const u32x4*)(Z + off), za, zb); pg8::unpack8(*(const u32x4*)(Bg + off), ba, bb);
            const f32x4 ya = w0a * za + w1a * zm1a + w2a * zm2a, yb = w0b * zb + w1b * zm1b + w2b * zm2b;
            *(u32x4*)(Bg + off) = pg8::pack8(ba * ya, bb * yb);
            zm2a = zm1a; zm2b = zm1b; zm1a = za; zm1b = zb; }
    }
}
__global__ void __launch_bounds__(NWAVES * 64, 2) fwd_megakernel(Args args) {
    extern __shared__ __attribute__((aligned(16))) unsigned char lds_raw[];
    cg::grid_group grid = cg::this_grid();
    LAS unsigned char* lds = (LAS unsigned char*)lds_raw;
    const int tid = threadIdx.x, lane = tid & 63, wave = __builtin_amdgcn_readfirstlane(tid >> 6);
    const int G = gridDim.x, bid = blockIdx.x;
    const int gw = bid * NWAVES + wave, ngw = G * NWAVES, gt = bid * (NWAVES * 64) + tid, ngt = G * NWAVES * 64;
    unsigned char* ws = args.ws;
    const float* x = args.in[0];
    float* out = args.out;
    bf16_t* Gt = (bf16_t*)out;

    p0_weights(args, ws, (LAS float*)(lds + wave * 16640), gw, ngw, lane);
    { bf16_t* xb = (bf16_t*)(ws + WS_XB);
      for (size_t i = gt; i < (size_t)M * DM / 8; i += ngt) { const f32x4 a = *(const f32x4*)(x + i * 8), b = *(const f32x4*)(x + i * 8 + 4); *(u32x4*)(xb + i * 8) = pg8::pack8(a, b); } }
    grid.sync();
    { pg8::Gemm g{(const bf16_t*)(ws + WS_XB), (const bf16_t*)(ws + WS_WIN), M, INC, DM}; pg8::StaticOrder S; S.init(M, INC, G, bid);
      pg8::EpiInProj E{(bf16_t*)(ws + WS_QKV), (bf16_t*)(ws + WS_Z), (bf16_t*)(ws + WS_BG), Gt, QSCALE};
      pg8::gemm_phase<pg8::EpiInProj, pg8::StaticOrder, true, true>(lds, g, S, E); }
    grid.sync();
    attn_phase(ws, lds, G, bid, tid, wave, lane);
    conv_phase(args.in[2], ws, gt, ngt);
    grid.sync();
    p3_weights(args, ws, (LAS float*)(lds + wave * 16640), gw, ngw, lane);
    __syncthreads();
    { pg8::Gemm g{(const bf16_t*)(ws + WS_AH), (const bf16_t*)(ws + WS_WAO), M, DM, AOW}; pg8::StaticOrder S; S.init(M, DM, G, bid);
      pg8::EpiGateMul E{Gt, 4096, (bf16_t*)(ws + WS_T)};
      pg8::gemm_phase<pg8::EpiGateMul, pg8::StaticOrder, true, true>(lds, g, S, E); }
    { pg8::Gemm g{(const bf16_t*)(ws + WS_BG), (const bf16_t*)(ws + WS_WCO), M, DM, DM}; pg8::StaticOrder S; S.init(M, DM, G, bid);
      pg8::EpiGateMulAdd E{Gt + 2048, 4096, (const bf16_t*)(ws + WS_T), (bf16_t*)(ws + WS_MG)};
      pg8::gemm_phase<pg8::EpiGateMulAdd, pg8::StaticOrder, true, true>(lds, g, S, E); }
    grid.sync();
    { pg8::Gemm g{(const bf16_t*)(ws + WS_MG), (const bf16_t*)(ws + WS_WOUT), M, DM, DM}; pg8::StaticOrder S; S.init(M, DM, G, bid);
      pg8::EpiResF32 E{x, out, ALPHA};
      pg8::gemm_phase<pg8::EpiResF32, pg8::StaticOrder, true, true>(lds, g, S, E); }
    grid.sync();
    ln_rows(out, args.in[6], args.in[7], (bf16_t*)(ws + WS_X1B), gw, ngw, lane);
    grid.sync();
    { pg8::Gemm g{(const bf16_t*)(ws + WS_X1B), (const bf16_t*)(ws + WS_WGU), M, 2 * FFN, DM}; pg8::StaticOrder S; S.init(M, 2 * FFN, G, bid);
      pg8::EpiSwiGlu E{(bf16_t*)(ws + WS_H)};
      pg8::gemm_phase<pg8::EpiSwiGlu, pg8::StaticOrder, true, true>(lds, g, S, E); }
    grid.sync();
    { pg8::Gemm g{(const bf16_t*)(ws + WS_H), (const bf16_t*)(ws + WS_WDN), M, DM, FFN}; pg8::StaticOrder S; S.init(M, DM, G, bid);
      pg8::EpiResF32 E{out, out, ALPHA};
      pg8::gemm_phase<pg8::EpiResF32, pg8::StaticOrder, true, true>(lds, g, S, E); }
    grid.sync();
    ln_rows(out, args.in[11], args.in[12], nullptr, gw, ngw, lane);
}

extern "C" void kernel_launch(void* const* d_in, const int* in_sizes, int n_in, void* d_out, int out_size, void* d_ws, size_t ws_size, hipStream_t stream) {
    static int grid = 0;
    if (grid == 0) {
        if (n_in != 13 || out_size != M * DM || ws_size < WS_NEED) { fprintf(stderr, "kernel_launch: unexpected problem (n_in %d, out %d, ws %zu)\n", n_in, out_size, ws_size); grid = -1; return; }
        int dev = 0, cus = 0, per_cu = 0;
        (void)hipGetDevice(&dev); (void)hipDeviceGetAttribute(&cus, hipDeviceAttributeMultiprocessorCount, dev);
        (void)hipFuncSetAttribute((const void*)fwd_megakernel, hipFuncAttributeMaxDynamicSharedMemorySize, LDS_BYTES);
        (void)hipOccupancyMaxActiveBlocksPerMultiprocessor(&per_cu, (const void*)fwd_megakernel, NWAVES * 64, LDS_BYTES);
        if (per_cu < 1) per_cu = 1;
        if (cus < 1) cus = 256;
        grid = cus;
        (void)hipGetLastError();
    }
    if (grid < 0) return;
    Args a{};
    for (int i = 0; i < 13; ++i) a.in[i] = (const float*)d_in[i];
    a.out = (float*)d_out; a.ws = (unsigned char*)d_ws;
    void* kargs[] = {&a};
    hipError_t e = hipLaunchCooperativeKernel((const void*)fwd_megakernel, dim3(grid), dim3(NWAVES * 64), kargs, LDS_BYTES, stream);
    if (e != hipSuccess) fprintf(stderr, "cooperative launch failed: %s (grid %d)\n", hipGetErrorString(e), grid);
}
```

```cpp
#include <hip/hip_runtime.h>
#include <hip/hip_cooperative_groups.h>
#include <cstdio>
#include <cstdint>
namespace cg = cooperative_groups;
namespace pg8 {
#define PG8_LAS __attribute__((address_space(3)))
typedef unsigned short bf16_t;
typedef short bf16x8 __attribute__((ext_vector_type(8)));
typedef float f32x4 __attribute__((ext_vector_type(4)));
typedef unsigned u32x4 __attribute__((ext_vector_type(4)));
constexpr int BM = 256, BK = 64, HALF = 128, HTB = HALF * BK * 2  , STAGE_BYTES = 8 * HTB, NXCD = 8, WGM = 8;

__host__ __device__ __forceinline__ int lds_byte(int r, int c) { const int st = (r >> 4) * 2 + (c >> 5), rr = r & 15, cc = c & 31, ob = rr * 64 + cc * 2; return st * 1024 + (ob ^ (((ob >> 9) & 1) << 5)); }
__host__ __device__ __forceinline__ void stage_rc(int b, int& R, int& C) { const int st = b / 1024, sb = b % 1024, swz = sb ^ (((sb >> 9) & 1) << 5); R = (st >> 1) * 16 + swz / 64; C = (st & 1) * 32 + (swz % 64) / 2; }
__host__ __device__ __forceinline__ int perm32(int rho) { const int n = rho >> 4, i = rho & 15; return 8 * (i >> 2) + 4 * n + (i & 3); }

struct Unit { int pm, pn; };
struct Gemm { const bf16_t* A; const bf16_t* Bt; int M, N, K; };

struct StaticOrder {
    int nM, nN, nwg, G, c;
    __host__ __device__ void init(int M, int N, int G_, int c_) { nM = M / BM; nN = N / BM; nwg = nM * nN; G = G_; c = c_; }
    __host__ __device__ bool next(int i, Unit& u) const {
        const long L = (long)i * G + c; if (L >= nwg) return false;
        int wgid = (int)L; { const int q = nwg / NXCD, r = nwg % NXCD, xcd = wgid % NXCD, off = wgid / NXCD; wgid = (xcd < r ? xcd * (q + 1) : r * (q + 1) + (xcd - r) * q) + off; }
        const int nig = WGM * nN, gid = wgid / nig, fm = gid * WGM, gsz = (nM - fm) < WGM ? (nM - fm) : WGM;
        u.pm = fm + ((wgid % nig) % gsz); u.pn = (wgid % nig) / gsz; return true;
    }
    __device__ __forceinline__ void a_ready(const Unit&) const {}
    __device__ __forceinline__ void done(const Unit&) const {}
};

__device__ __forceinline__ unsigned cvt_pk_bf16(float lo, float hi) { unsigned r; asm volatile("v_cvt_pk_bf16_f32 %0, %1, %2" : "=v"(r) : "v"(lo), "v"(hi)); return r; }
__device__ __forceinline__ float sigmoid_f(float v) { return __builtin_amdgcn_rcpf(1.0f + __builtin_amdgcn_exp2f(-1.4426950408889634f * v)); }
__device__ __forceinline__ u32x4 pack8(const f32x4 a, const f32x4 b) { u32x4 w; w.x = cvt_pk_bf16(a[0], a[1]); w.y = cvt_pk_bf16(a[2], a[3]); w.z = cvt_pk_bf16(b[0], b[1]); w.w = cvt_pk_bf16(b[2], b[3]); return w; }
__device__ __forceinline__ void unpack8(const u32x4 w, f32x4& a, f32x4& b) {
    a[0] = __uint_as_float(w.x << 16); a[1] = __uint_as_float(w.x & 0xffff0000u); a[2] = __uint_as_float(w.y << 16); a[3] = __uint_as_float(w.y & 0xffff0000u);
    b[0] = __uint_as_float(w.z << 16); b[1] = __uint_as_float(w.z & 0xffff0000u); b[2] = __uint_as_float(w.w << 16); b[3] = __uint_as_float(w.w & 0xffff0000u); }

struct EpiInProj {
    static constexpr bool PERM = true, AFTER_DRAIN = false;
    bf16_t* QKV; bf16_t* Z; bf16_t* Bg; bf16_t* G; float qscale;
    __device__ __forceinline__ void operator()(const f32x4 (&acc)[2][2][4][2], const Unit& u, int wr, int wc, int fr, int fq) const {
        const int row0 = u.pm * BM + wr * 64 + fr, cl = wc * 32 + 8 * fq;
        if (u.pn < 36) {
            const float sc = (u.pn < 12) ? qscale : 1.0f;
#pragma unroll
            for (int ai = 0; ai < 2; ++ai)
#pragma unroll
                for (int m = 0; m < 4; ++m) { bf16_t* rowp = QKV + (size_t)(row0 + ai * HALF + m * 16) * 9216 + u.pn * BM + cl;
#pragma unroll
                    for (int bj = 0; bj < 2; ++bj) *(u32x4*)(rowp + bj * HALF) = pack8(acc[ai][bj][m][0] * sc, acc[ai][bj][m][1] * sc); }
        } else if (u.pn < 52) {
            const int cb = (u.pn - 36) * HALF + cl;
#pragma unroll
            for (int ai = 0; ai < 2; ++ai)
#pragma unroll
                for (int m = 0; m < 4; ++m) *(u32x4*)(Z + (size_t)(row0 + ai * HALF + m * 16) * 2048 + cb) = pack8(acc[ai][0][m][0] * acc[ai][1][m][0], acc[ai][0][m][1] * acc[ai][1][m][1]);
        } else if (u.pn < 60) {
            const int cb = (u.pn - 52) * BM + cl;
#pragma unroll
            for (int ai = 0; ai < 2; ++ai)
#pragma unroll
                for (int m = 0; m < 4; ++m) { bf16_t* rowp = Bg + (size_t)(row0 + ai * HALF + m * 16) * 2048 + cb;
#pragma unroll
                    for (int bj = 0; bj < 2; ++bj) *(u32x4*)(rowp + bj * HALF) = pack8(acc[ai][bj][m][0], acc[ai][bj][m][1]); }
        } else {
            const int cb = (u.pn - 60) * BM + cl;
#pragma unroll
            for (int ai = 0; ai < 2; ++ai)
#pragma unroll
                for (int m = 0; m < 4; ++m) { bf16_t* rowp = G + (size_t)(row0 + ai * HALF + m * 16) * 4096 + cb;
#pragma unroll
                    for (int bj = 0; bj < 2; ++bj) { f32x4 a = acc[ai][bj][m][0], b = acc[ai][bj][m][1];
#pragma unroll
                        for (int e = 0; e < 4; ++e) { a[e] = sigmoid_f(a[e]); b[e] = sigmoid_f(b[e]); }
                        *(u32x4*)(rowp + bj * HALF) = pack8(a, b); } }
        }
    }
};
struct EpiGateMul {
    static constexpr bool PERM = true, AFTER_DRAIN = false;
    const bf16_t* G; int ldg; bf16_t* T;
    __device__ __forceinline__ void operator()(const f32x4 (&acc)[2][2][4][2], const Unit& u, int wr, int wc, int fr, int fq) const {
        const int row0 = u.pm * BM + wr * 64 + fr, col0 = u.pn * BM + wc * 32 + 8 * fq;
#pragma unroll
        for (int ai = 0; ai < 2; ++ai)
#pragma unroll
            for (int m = 0; m < 4; ++m) { const size_t r = (size_t)(row0 + ai * HALF + m * 16);
#pragma unroll
                for (int bj = 0; bj < 2; ++bj) { f32x4 ga, gb; unpack8(*(const u32x4*)(G + r * ldg + col0 + bj * HALF), ga, gb);
                    *(u32x4*)(T + r * 2048 + col0 + bj * HALF) = pack8(acc[ai][bj][m][0] * ga, acc[ai][bj][m][1] * gb); } }
    }
};
struct EpiGateMulAdd {
    static constexpr bool PERM = true, AFTER_DRAIN = false;
    const bf16_t* G; int ldg; const bf16_t* T; bf16_t* O;
    __device__ __forceinline__ void operator()(const f32x4 (&acc)[2][2][4][2], const Unit& u, int wr, int wc, int fr, int fq) const {
        const int row0 = u.pm * BM + wr * 64 + fr, col0 = u.pn * BM + wc * 32 + 8 * fq;
#pragma unroll
        for (int ai = 0; ai < 2; ++ai)
#pragma unroll
            for (int m = 0; m < 4; ++m) { const size_t r = (size_t)(row0 + ai * HALF + m * 16);
#pragma unroll
                for (int bj = 0; bj < 2; ++bj) { f32x4 ga, gb, ta, tb; unpack8(*(const u32x4*)(G + r * ldg + col0 + bj * HALF), ga, gb); unpack8(*(const u32x4*)(T + r * 2048 + col0 + bj * HALF), ta, tb);
                    *(u32x4*)(O + r * 2048 + col0 + bj * HALF) = pack8(ta + acc[ai][bj][m][0] * ga, tb + acc[ai][bj][m][1] * gb); } }
    }
};
struct EpiResF32 {
    static constexpr bool PERM = false, AFTER_DRAIN = false;
    const float* base; float* out; float alpha;
    __device__ __forceinline__ void operator()(const f32x4 (&acc)[2][2][4][2], const Unit& u, int wr, int wc, int fr, int fq) const {
        const int row0 = u.pm * BM + wr * 64 + fr, col0 = u.pn * BM + wc * 32 + 4 * fq;
#pragma unroll
        for (int ai = 0; ai < 2; ++ai)
#pragma unroll
            for (int m = 0; m < 4; ++m) { const size_t off = (size_t)(row0 + ai * HALF + m * 16) * 2048 + col0;
#pragma unroll
                for (int bj = 0; bj < 2; ++bj)
#pragma unroll
                    for (int n = 0; n < 2; ++n) { const f32x4 bs = *(const f32x4*)(base + off + bj * HALF + n * 16); *(f32x4*)(out + off + bj * HALF + n * 16) = bs * alpha + acc[ai][bj][m][n]; } }
    }
};
struct EpiSwiGlu {
    static constexpr bool PERM = true, AFTER_DRAIN = false;
    bf16_t* H;
    __device__ __forceinline__ void operator()(const f32x4 (&acc)[2][2][4][2], const Unit& u, int wr, int wc, int fr, int fq) const {
        const int row0 = u.pm * BM + wr * 64 + fr, cb = u.pn * HALF + wc * 32 + 8 * fq;
#pragma unroll
        for (int ai = 0; ai < 2; ++ai)
#pragma unroll
            for (int m = 0; m < 4; ++m) { f32x4 a = acc[ai][0][m][0], b = acc[ai][0][m][1];
#pragma unroll
                for (int e = 0; e < 4; ++e) { a[e] = a[e] * sigmoid_f(a[e]); b[e] = b[e] * sigmoid_f(b[e]); }
                *(u32x4*)(H + (size_t)(row0 + ai * HALF + m * 16) * 5632 + cb) = pack8(a * acc[ai][1][m][0], b * acc[ai][1][m][1]); }
    }
};
template <class Epi, class Sched, bool ALIGN_EPI = false, bool SP2 = false>
__device__ __forceinline__ void gemm_phase(PG8_LAS unsigned char* lds, const Gemm g, const Sched& S, const Epi& E) {
    const int tid = threadIdx.x, wid = __builtin_amdgcn_readfirstlane(tid >> 6), lane = tid & 63, wr = wid >> 2, wc = wid & 3, fr = lane & 15, fq = lane >> 4;
    const int K = g.K, nt = K / BK;
    unsigned voffA[2], voffB[2];
#pragma unroll
    for (int i = 0; i < 2; ++i) { int R, C; stage_rc(tid * 16 + i * 8192, R, C); const int Rb = Epi::PERM ? ((R & ~31) + perm32(R & 31)) : R;
        voffA[i] = (unsigned)(R * K + C) * 2u; voffB[i] = (unsigned)(Rb * K + C) * 2u; }
    const size_t kstep = (size_t)(BK * 2);
    const size_t hstep = (size_t)HALF * K * 2;
    const size_t tstep = 2 * hstep;
    const unsigned ldsw = (unsigned)wid * 1024u;
    const int aoff = lds_byte(wr * 64 + fr, fq * 8), boff = lds_byte(wc * 32 + fr, fq * 8);
#define PG8_SA(b, h) (((b) * 2 + (h)) * HTB)
#define PG8_SB(b, h) ((4 + (b) * 2 + (h)) * HTB)
#define PG8_STAGE(bufoff, gbase, voff) do { _Pragma("unroll") for (int _i = 0; _i < 2; ++_i) \
        __builtin_amdgcn_global_load_lds((const unsigned*)((const char*)(gbase) + (voff)[_i]), (PG8_LAS unsigned*)(lds + (bufoff) + ldsw + _i * 8192), 16, 0, 0); } while (0)
#define PG8_LDA(dst, b, h) do { _Pragma("unroll") for (int m = 0; m < 4; ++m) _Pragma("unroll") for (int k = 0; k < 2; ++k) dst[m][k] = *(const PG8_LAS bf16x8*)(lds + PG8_SA(b, h) + aoff + m * 2048 + k * 1024); } while (0)
#define PG8_LDB(dst, b, h) do { _Pragma("unroll") for (int n = 0; n < 2; ++n) _Pragma("unroll") for (int k = 0; k < 2; ++k) dst[n][k] = *(const PG8_LAS bf16x8*)(lds + PG8_SB(b, h) + boff + n * 2048 + k * 1024); } while (0)
#define PG8_MMA(ai, bj, At, Bt) do { __builtin_amdgcn_s_setprio(1); _Pragma("unroll") for (int m = 0; m < 4; ++m) _Pragma("unroll") for (int n = 0; n < 2; ++n) _Pragma("unroll") for (int k = 0; k < 2; ++k) \
        acc[ai][bj][m][n] = __builtin_amdgcn_mfma_f32_16x16x32_bf16(Bt[n][k], At[m][k], acc[ai][bj][m][n], 0, 0, 0); __builtin_amdgcn_s_setprio(0); } while (0)
#define PG8_WAIT_V(n) asm volatile("s_waitcnt vmcnt(" #n ")" ::: "memory")
#define PG8_WAIT_L(n) asm volatile("s_waitcnt lgkmcnt(" #n ")" ::: "memory")
#define PG8_BAR __builtin_amdgcn_s_barrier()
#define PG8_SCHED __builtin_amdgcn_sched_barrier(0)
    Unit cur, nxt; int ui = 0;
    if (!S.next(0, cur)) return;
    f32x4 acc[2][2][4][2];
#pragma unroll
    for (int a = 0; a < 2; ++a)
#pragma unroll
        for (int b = 0; b < 2; ++b)
#pragma unroll
            for (int m = 0; m < 4; ++m)
#pragma unroll
                for (int n = 0; n < 2; ++n) acc[a][b][m][n] = (f32x4){0.f, 0.f, 0.f, 0.f};
    bf16x8 At[4][2], B0[2][2], B1[2][2];
    const char* cA = (const char*)g.A + (size_t)cur.pm * tstep; const char* cB = (const char*)g.Bt + (size_t)cur.pn * tstep;
    S.a_ready(cur);
    if constexpr (SP2) {
        PG8_STAGE(PG8_SB(0, 0), cB, voffB); PG8_STAGE(PG8_SB(0, 1), cB + hstep, voffB); PG8_STAGE(PG8_SA(0, 0), cA, voffA); PG8_STAGE(PG8_SA(0, 1), cA + hstep, voffA);
        if (wr == 1) PG8_BAR;
        PG8_WAIT_V(2); PG8_BAR;
        PG8_STAGE(PG8_SB(1, 0), cB + kstep, voffB); PG8_STAGE(PG8_SA(1, 0), cA + kstep, voffA); PG8_STAGE(PG8_SB(1, 1), cB + hstep + kstep, voffB);
        PG8_WAIT_V(6); PG8_BAR;
    } else {
        PG8_STAGE(PG8_SB(0, 0), cB, voffB); PG8_STAGE(PG8_SA(0, 0), cA, voffA); PG8_STAGE(PG8_SB(0, 1), cB + hstep, voffB); PG8_STAGE(PG8_SA(0, 1), cA + hstep, voffA);
        if (wr == 1) PG8_BAR;
        PG8_WAIT_V(4); PG8_BAR;
        PG8_STAGE(PG8_SB(1, 0), cB + kstep, voffB); PG8_STAGE(PG8_SA(1, 0), cA + kstep, voffA); PG8_STAGE(PG8_SB(1, 1), cB + hstep + kstep, voffB);
        PG8_WAIT_V(6); PG8_BAR;
    }
    for (;;) {
        const bool has_next = S.next(ui + 1, nxt);
        const char* nA = has_next ? (const char*)g.A + (size_t)nxt.pm * tstep : cA; const char* nB = has_next ? (const char*)g.Bt + (size_t)nxt.pn * tstep : cB;
        for (int t = 0; t < nt; t += 2) {
            const bool last = (t == nt - 2);
            const char* a1 = cA + (size_t)(t + 1) * kstep;
            const char* a2 = last ? nA : cA + (size_t)(t + 2) * kstep; const char* b2 = last ? nB : cB + (size_t)(t + 2) * kstep;
            const char* a3 = a2 + kstep; const char* b3 = b2 + kstep;
            if (last && has_next) S.a_ready(nxt);
            if constexpr (SP2) {
            PG8_LDB(B0, 0, 0); PG8_LDB(B1, 0, 1); PG8_SCHED; PG8_LDA(At, 0, 0); PG8_STAGE(PG8_SA(1, 1), a1 + hstep, voffA);
            PG8_WAIT_V(8); PG8_WAIT_L(0); PG8_BAR; PG8_MMA(0, 0, At, B0); PG8_MMA(0, 1, At, B1); PG8_BAR; PG8_SCHED;
            PG8_LDA(At, 0, 1); PG8_STAGE(PG8_SB(0, 0), b2, voffB); PG8_STAGE(PG8_SB(0, 1), b2 + hstep, voffB); PG8_STAGE(PG8_SA(0, 0), a2, voffA);
            PG8_WAIT_V(8); PG8_WAIT_L(0); PG8_BAR; PG8_MMA(1, 0, At, B0); PG8_MMA(1, 1, At, B1); PG8_BAR; PG8_SCHED;
            PG8_LDB(B0, 1, 0); PG8_LDB(B1, 1, 1); PG8_SCHED; PG8_LDA(At, 1, 0); PG8_STAGE(PG8_SA(0, 1), a2 + hstep, voffA);
            PG8_WAIT_V(8); PG8_WAIT_L(0); PG8_BAR; PG8_MMA(0, 0, At, B0); PG8_MMA(0, 1, At, B1); PG8_BAR; PG8_SCHED;
            PG8_LDA(At, 1, 1); PG8_STAGE(PG8_SB(1, 0), b3, voffB); PG8_STAGE(PG8_SB(1, 1), b3 + hstep, voffB); PG8_STAGE(PG8_SA(1, 0), a3, voffA);
            PG8_WAIT_V(8); PG8_WAIT_L(0); PG8_BAR; PG8_MMA(1, 0, At, B0); PG8_MMA(1, 1, At, B1); PG8_BAR; PG8_SCHED;
            } else {
            PG8_LDB(B0, 0, 0); PG8_SCHED; PG8_LDA(At, 0, 0); PG8_STAGE(PG8_SA(1, 1), a1 + hstep, voffA);
            PG8_WAIT_L(8); PG8_BAR; PG8_WAIT_L(0); PG8_MMA(0, 0, At, B0); PG8_BAR; PG8_SCHED;
            PG8_LDB(B1, 0, 1); PG8_STAGE(PG8_SB(0, 0), b2, voffB);
            PG8_BAR; PG8_WAIT_L(0); PG8_MMA(0, 1, At, B1); PG8_BAR;
            PG8_LDA(At, 0, 1); PG8_STAGE(PG8_SA(0, 0), a2, voffA);
            PG8_BAR; PG8_WAIT_L(0); PG8_MMA(1, 0, At, B0); PG8_BAR; PG8_SCHED;
            PG8_STAGE(PG8_SB(0, 1), b2 + hstep, voffB);
            PG8_WAIT_V(6); PG8_BAR; PG8_MMA(1, 1, At, B1); PG8_BAR;
            PG8_LDB(B0, 1, 0); PG8_SCHED; PG8_LDA(At, 1, 0); PG8_STAGE(PG8_SA(0, 1), a2 + hstep, voffA);
            PG8_WAIT_L(8); PG8_BAR; PG8_WAIT_L(0); PG8_MMA(0, 0, At, B0); PG8_BAR; PG8_SCHED;
            PG8_LDB(B1, 1, 1); PG8_STAGE(PG8_SB(1, 0), b3, voffB);
            PG8_BAR; PG8_WAIT_L(0); PG8_MMA(0, 1, At, B1); PG8_BAR;
            PG8_LDA(At, 1, 1); PG8_STAGE(PG8_SA(1, 0), a3, voffA);
            PG8_BAR; PG8_WAIT_L(0); PG8_MMA(1, 0, At, B0); PG8_BAR; PG8_SCHED;
            PG8_STAGE(PG8_SB(1, 1), b3 + hstep, voffB);
            PG8_WAIT_V(6); PG8_BAR; PG8_MMA(1, 1, At, B1); PG8_BAR;
            }
        }
        if constexpr (ALIGN_EPI) { if (wr == 0) PG8_BAR; }
        if constexpr (!Epi::AFTER_DRAIN) { E(acc, cur, wr, wc, fr, fq); S.done(cur); }
        if (!has_next) break;
#pragma unroll
        for (int a = 0; a < 2; ++a)
#pragma unroll
            for (int b = 0; b < 2; ++b)
#pragma unroll
                for (int m = 0; m < 4; ++m)
#pragma unroll
                    for (int n = 0; n < 2; ++n) acc[a][b][m][n] = (f32x4){0.f, 0.f, 0.f, 0.f};
        cur = nxt; cA = nA; cB = nB; ++ui;
        if constexpr (ALIGN_EPI) { if (wr == 1) PG8_BAR; }
    }
    PG8_WAIT_V(0);
    if constexpr (!ALIGN_EPI) { if (wr == 0) PG8_BAR; }
    PG8_BAR;
    if constexpr (Epi::AFTER_DRAIN) { E.fused(acc, cur, wr, wc, fr, fq, lds, wid, lane); S.done(cur); }
#undef PG8_SA
#undef PG8_SB
#undef PG8_STAGE
#undef PG8_LDA
#undef PG8_LDB
#undef PG8_MMA
#undef PG8_WAIT_V
#undef PG8_WAIT_L
#undef PG8_BAR
#undef PG8_SCHED
}
}
constexpr int BATCH = 8, SEQ = 2048, DM = 2048, M = BATCH * SEQ;
constexpr int INC = 19456, QKVW = 9216, FFN = 5632, AOW = 1024;
constexpr float LN_EPS = 1e-5f, ALPHA = 1.189207115002721f;
constexpr float QSCALE = 0.08838834764831845f * 1.4426950408889634f;
constexpr size_t MiB = 1u << 20;
constexpr size_t WS_WAO = 1 * MiB, WS_WCO = 5 * MiB, WS_WOUT = 13 * MiB;
constexpr size_t WS_WIN = 21 * MiB;
constexpr size_t WS_XB = 97 * MiB;
constexpr size_t WS_QKV = 161 * MiB;
constexpr size_t WS_Z = 449 * MiB;
constexpr size_t WS_BG = 513 * MiB;
constexpr size_t WS_PO = 21 * MiB;
constexpr size_t WS_LSE = 117 * MiB;
constexpr size_t WS_AH = 119 * MiB;
constexpr size_t WS_T = 161 * MiB, WS_MG = 225 * MiB;
constexpr size_t WS_WGU = 289 * MiB, WS_WDN = 333 * MiB;
constexpr size_t WS_X1B = 355 * MiB;
constexpr size_t WS_H = 21 * MiB;
constexpr size_t WS_NEED = 608 * MiB;
constexpr int LDS_BYTES = 147456, NWAVES = 8;
constexpr int CW_BAR = 4096;
constexpr size_t CTL_ZERO_BYTES = 65536;

#define LAS __attribute__((address_space(3)))
typedef pg8::bf16_t bf16_t;
typedef pg8::f32x4 f32x4;
typedef pg8::u32x4 u32x4;
typedef pg8::bf16x8 bf16x8;
typedef float f32x16 __attribute__((ext_vector_type(16)));
typedef short s16x4 __attribute__((ext_vector_type(4)));
using pg8::cvt_pk_bf16;

#define GAS __attribute__((address_space(1)))
typedef unsigned v4u __attribute__((ext_vector_type(4)));
typedef GAS unsigned gu32;
typedef GAS unsigned long long gu64;
#define RLX_AGENT __ATOMIC_RELAXED, __HIP_MEMORY_SCOPE_AGENT
#define LDS_WAIT() asm volatile("s_waitcnt lgkmcnt(0)" ::: "memory")
#define VM_WAIT() asm volatile("s_waitcnt vmcnt(0)" ::: "memory")
__device__ __forceinline__ unsigned long long rt() { return __builtin_amdgcn_s_memrealtime(); }
__device__ __forceinline__ unsigned f2bf(float f) { unsigned u = __builtin_bit_cast(unsigned, f); return (u + 0x7fffu + ((u >> 16) & 1u)) >> 16; }
__device__ __forceinline__ unsigned pk2(float lo, float hi) { return f2bf(lo) | (f2bf(hi) << 16); }

#define XB_TMO      128
#define XB_XCNT(j)  (256  + 64 * (j))
#define XB_XSUB(j)  (1280 + 64 * (j))
#define XB_XGEN(j)  (2304 + 64 * (j))
#define XB_TOP      3328
#define XB_TOPGEN   3392
#define XCD_BAR_WORDS 3456
#define XB_SPIN_CAP (1u << 18)

__device__ __forceinline__ unsigned xb_ld(unsigned* p)              { return __hip_atomic_load(p, __ATOMIC_RELAXED, __HIP_MEMORY_SCOPE_AGENT); }
__device__ __forceinline__ unsigned xb_add(unsigned* p, unsigned v) { return __hip_atomic_fetch_add(p, v, __ATOMIC_RELAXED, __HIP_MEMORY_SCOPE_AGENT); }
__device__ __forceinline__ unsigned xb_xcc_id() { return (unsigned)__builtin_amdgcn_s_getreg((3 << 11) | 20) & 0xFu; }
#define XB_SPIN(cond, bar) do { unsigned _sp = 0; while (cond) { __builtin_amdgcn_s_sleep(1); \
    if ((++_sp & 255u) == 0u) { if (xb_ld(&(bar)[XB_TMO])) break; if (_sp > XB_SPIN_CAP) { atomicAdd(&(bar)[XB_TMO], 1u); break; } } } } while (0)

struct XcdBarrier {
    unsigned* bar; unsigned x;
    volatile LAS unsigned* st;
};

__device__ __forceinline__ XcdBarrier xcd_barrier_post(unsigned* bar, volatile LAS unsigned* st) {
    XcdBarrier b; b.bar = bar; b.x = xb_xcc_id(); b.st = st;
    if (threadIdx.x == 0) (void)xb_add(&bar[XB_XCNT(b.x)], 1u);
    return b;
}
__device__ __forceinline__ void xcd_barrier_complete(unsigned* bar, unsigned x, unsigned& nloc, unsigned& nx) {
    const unsigned G = gridDim.x * gridDim.y * gridDim.z;
    unsigned sum, cnt, mine, sp = 0u;
    for (;;) {
        sum = 0u; cnt = 0u; mine = 0u;
#pragma unroll
        for (unsigned j = 0; j < 16; ++j) { const unsigned c = xb_ld(&bar[XB_XCNT(j)]); sum += c; cnt += (c > 0u) ? 1u : 0u; mine = (j == x) ? c : mine; }
        if (sum == G) break;
        __builtin_amdgcn_s_sleep(1);
        if ((++sp & 255u) == 0u) { if (xb_ld(&bar[XB_TMO])) break; if (sp > XB_SPIN_CAP) { atomicAdd(&bar[XB_TMO], 1u); break; } }
    }
    nloc = mine > 0u ? mine : 1u; nx = cnt > 0u ? cnt : 1u;
}

__device__ __forceinline__ void xcd_barrier(const XcdBarrier& b) {
    asm volatile("s_waitcnt vmcnt(0)" ::: "memory");
    __syncthreads();
    if (threadIdx.x == 0) {
        unsigned* bar = b.bar;
        __builtin_amdgcn_s_waitcnt(0);
        unsigned nloc = b.st[0], nx = b.st[1];
        if (nloc == 0u) { xcd_barrier_complete(bar, b.x, nloc, nx); b.st[0] = nloc; b.st[1] = nx; }
        const unsigned old = xb_add(&bar[XB_XSUB(b.x)], 1u);
        const unsigned gen = old / nloc;
        if (old + 1u == (gen + 1u) * nloc) {
            __builtin_amdgcn_fence(__ATOMIC_RELEASE, "agent");
            asm volatile("s_waitcnt vmcnt(0)" ::: "memory");
            const unsigned og = xb_add(&bar[XB_TOP], 1u);
            const unsigned tg = og / nx;
            if (og + 1u == (tg + 1u) * nx) xb_add(&bar[XB_TOPGEN], 1u);
            else XB_SPIN(xb_ld(&bar[XB_TOPGEN]) == tg, bar);
            __builtin_amdgcn_fence(__ATOMIC_ACQUIRE, "agent");
            xb_add(&bar[XB_XGEN(b.x)], 1u);
            asm volatile("s_waitcnt vmcnt(0)" ::: "memory");
        } else {
            XB_SPIN(xb_ld(&bar[XB_XGEN(b.x)]) == gen, bar);
            __builtin_amdgcn_fence(__ATOMIC_ACQUIRE, "agent");
            asm volatile("s_waitcnt vmcnt(0)" ::: "memory");
        }
    }
    __syncthreads();
}

struct Args { const float* in[13]; float* out; unsigned char* ws; };

__device__ __forceinline__ float wave_sum(float v) {
#pragma unroll
    for (int o = 1; o < 64; o <<= 1) v += __shfl_xor(v, o);
    return v;
}
__device__ __forceinline__ void tr_item(const float* __restrict__ src, int ldn, int c0, int k0, bf16_t* __restrict__ dst, int K, int r0, LAS float* scr, int lane) {
    f32x4 v[16];
#pragma unroll
    for (int i = 0; i < 16; ++i) v[i] = *(const f32x4*)(src + (size_t)(k0 + 4 * i + (lane >> 4)) * ldn + c0 + (lane & 15) * 4);
#pragma unroll
    for (int i = 0; i < 16; ++i) { LAS float* p = scr + (4 * i + (lane >> 4)) * 65 + (lane & 15) * 4; p[0] = v[i][0]; p[1] = v[i][1]; p[2] = v[i][2]; p[3] = v[i][3]; }
    asm volatile("s_waitcnt lgkmcnt(0)" ::: "memory");
    const int c = lane & 7;
#pragma unroll
    for (int j = 0; j < 8; ++j) { const int n = (lane >> 3) + 8 * j; const LAS float* s = scr + (8 * c) * 65 + n;
        u32x4 o; o.x = cvt_pk_bf16(s[0], s[65]); o.y = cvt_pk_bf16(s[130], s[195]); o.z = cvt_pk_bf16(s[260], s[325]); o.w = cvt_pk_bf16(s[390], s[455]);
        *(u32x4*)(dst + (size_t)(r0 + n) * K + k0 + 8 * c) = o; }
    asm volatile("s_waitcnt lgkmcnt(0)" ::: "memory");
}
__device__ __forceinline__ void p0_weights(const Args& a, unsigned char* ws, LAS float* scr, int gw, int ngw, int lane) {
    constexpr int I_IN = 304 * 32, I_AO = 32 * 16, I_CO = 32 * 32, I_OUT = 32 * 32;
    for (int it = gw; it < I_IN + I_AO + I_CO + I_OUT; it += ngw) {
        int r = it;
        if (r < I_IN) { const int kb = r / 304, rb = r % 304; int c0 = 64 * rb;
            if (rb >= 144 && rb < 208) { const int q = rb - 144; c0 = 9216 + ((q & 3) >> 1) * 2048 + 128 * (q >> 2) + 64 * (q & 1); }
            tr_item(a.in[1], INC, c0, 64 * kb, (bf16_t*)(ws + WS_WIN), 2048, 64 * rb, scr, lane); continue; } r -= I_IN;
        if (r < I_AO) { tr_item(a.in[3], 2048, 64 * (r % 32), 64 * (r / 32), (bf16_t*)(ws + WS_WAO), 1024, 64 * (r % 32), scr, lane); continue; } r -= I_AO;
        if (r < I_CO) { tr_item(a.in[4], 2048, 64 * (r % 32), 64 * (r / 32), (bf16_t*)(ws + WS_WCO), 2048, 64 * (r % 32), scr, lane); continue; } r -= I_CO;
        tr_item(a.in[5], 2048, 64 * (r % 32), 64 * (r / 32), (bf16_t*)(ws + WS_WOUT), 2048, 64 * (r % 32), scr, lane);
    }
}
__device__ __forceinline__ void p3_weights(const Args& a, unsigned char* ws, LAS float* scr, int gw, int ngw, int lane) {
    constexpr int I_GU = 176 * 32, I_DN = 32 * 88;
    for (int it = gw; it < I_GU + I_DN; it += ngw) {
        int r = it;
        if (r < I_GU) { const int kb = r / 176, rb = r % 176; const int c0 = 128 * (rb >> 2) + 64 * (rb & 1);
            tr_item(((rb & 3) >> 1) ? a.in[9] : a.in[8], FFN, c0, 64 * kb, (bf16_t*)(ws + WS_WGU), 2048, 64 * rb, scr, lane); continue; } r -= I_GU;
        tr_item(a.in[10], 2048, 64 * (r % 32), 64 * (r / 32), (bf16_t*)(ws + WS_WDN), FFN, 64 * (r % 32), scr, lane);
    }
}
__device__ __forceinline__ void ln_rows(float* Y, const float* __restrict__ g, const float* __restrict__ bt, bf16_t* ob, int gw, int ngw, int lane) {
    for (int row = gw; row < M; row += ngw) {
        f32x4* yr = (f32x4*)(Y + (size_t)row * DM) + lane;
        f32x4 v[8]; float s = 0.f;
#pragma unroll
        for (int j = 0; j < 8; ++j) { v[j] = yr[64 * j]; s += (v[j][0] + v[j][1]) + (v[j][2] + v[j][3]); }
        const float mean = wave_sum(s) * (1.0f / DM); float s2 = 0.f;
#pragma unroll
        for (int j = 0; j < 8; ++j) { v[j] = v[j] - mean; s2 += (v[j][0] * v[j][0] + v[j][1] * v[j][1]) + (v[j][2] * v[j][2] + v[j][3] * v[j][3]); }
        const float rstd = 1.0f / sqrtf(wave_sum(s2) * (1.0f / DM) + LN_EPS);
#pragma unroll
        for (int j = 0; j < 8; ++j) { const f32x4 gg = ((const f32x4*)g)[lane + 64 * j], bb = ((const f32x4*)bt)[lane + 64 * j]; const f32x4 o = v[j] * rstd * gg + bb;
            yr[64 * j] = o;
            if (ob) { unsigned long long w = (unsigned long long)cvt_pk_bf16(o[0], o[1]) | ((unsigned long long)cvt_pk_bf16(o[2], o[3]) << 32); ((unsigned long long*)(ob + (size_t)row * DM))[lane + 64 * j] = w; } }
    }
}
__device__ __forceinline__ int crow(int r, int hi) { return (r & 3) + 8 * (r >> 2) + 4 * hi; }
__device__ __forceinline__ s16x4 vtr(LAS const unsigned char* p) { return __builtin_bit_cast(s16x4, __builtin_amdgcn_ds_read_tr16_b64_v4i16((LAS s16x4*)p)); }
__device__ __forceinline__ void glds16(const void* gsrc, unsigned lds_dst) { unsigned keep;
    asm volatile("s_mov_b32 %0, m0\n\ts_mov_b32 m0, %2\n\ts_nop 0\n\tglobal_load_lds_dwordx4 %1, off\n\ts_mov_b32 m0, %0" : "=&s"(keep) : "v"(gsrc), "s"(lds_dst) : "memory"); }
constexpr int ATT_NS = 6, ATT_SLOT = 16384;
#define ATT_WAITBAR(N) asm volatile("s_waitcnt vmcnt(" #N ")\n\ts_barrier" ::: "memory")
__device__ __forceinline__ void attn_unit(const bf16_t* __restrict__ QKV, bf16_t* __restrict__ PO, float* __restrict__ LSE, int ut, int v, LAS unsigned char* lds, int wave, int lane) {
    const int x = lane & 31, hi = lane >> 5;
    const int b = v >> 6, h = (v >> 3) & 7, rem = v & 7;
    int dil, NT, kt_start = 0, resA, res_w, i0;
    if (ut == 0) { dil = 1; kt_start = rem ? 8 * rem - 4 : 0; NT = 8 * rem + 8 - kt_start; resA = 0; res_w = 0; i0 = 256 * rem + 32 * wave; }
    else if (ut == 1) { const int QB = rem & 1; dil = 4; kt_start = QB ? 4 : 0; NT = 8 * QB + 8 - kt_start; resA = rem >> 1; res_w = resA; i0 = 256 * QB + 32 * wave; }
    else { dil = 16; NT = 8; resA = 2 * rem; res_w = resA + (wave >> 2); i0 = 32 * (wave & 3); }
    const int qt = i0 >> 5;
    const size_t rowbase = (size_t)b * SEQ;
    const int colq = ut * 1024 + h * 128;
    const unsigned l0 = (unsigned)(uintptr_t)lds;
    const bf16_t* ksrc = QKV + (rowbase + (size_t)dil * (4 * wave + (lane >> 4))) * QKVW + 3072 + colq + 8 * ((lane & 15) ^ ((lane >> 4) << 2) ^ (wave & 3));
#define ATT_DMA(j) do { const int j_ = (j); const int rj_ = (ut == 2) ? resA + (j_ >> 2) : resA, kj_ = (ut == 2) ? (j_ & 3) : kt_start + j_; \
        const bf16_t* p_ = ksrc + (size_t)(rj_ + dil * 32 * kj_) * QKVW; const unsigned d_ = l0 + (unsigned)(j_ % ATT_NS) * ATT_SLOT + 1024u * (unsigned)wave; \
        glds16(p_, (unsigned)__builtin_amdgcn_readfirstlane(d_)); glds16(p_ + 3072, (unsigned)__builtin_amdgcn_readfirstlane(d_ + 8192u)); } while (0)
#pragma unroll
    for (int j = 0; j < ATT_NS - 1; ++j) ATT_DMA(j);
    bf16x8 qf[8];
    { const bf16_t* qp = QKV + (rowbase + res_w + (size_t)dil * (i0 + x)) * QKVW + colq + 8 * hi;
#pragma unroll
      for (int d0 = 0; d0 < 8; ++d0) qf[d0] = *(const bf16x8*)(qp + 16 * d0); }
    const int kx = ((x & 3) << 2) | ((x >> 2) & 3);
    const int q4 = (lane & 15) >> 2, p4 = lane & 3, blk = (lane >> 4) & 1;
    int tra[4][2];
#pragma unroll
    for (int c = 0; c < 4; ++c)
#pragma unroll
        for (int t = 0; t < 2; ++t) { const int row = 8 * t + 4 * hi + q4, ch = 4 * c + 2 * blk + (p4 >> 1);
            tra[c][t] = 8192 + 256 * row + 16 * (ch ^ (((row & 3) << 2) | ((row >> 2) & 3))) + 8 * (p4 & 1); }
    f32x16 o[4];
#pragma unroll
    for (int c = 0; c < 4; ++c) o[c] = f32x16{};
    float mrun = -INFINITY, lrun = 0.f;
    for (int j = 0; j < NT; ++j) {
        const int y = ((j + ATT_NS - 2 < NT - 1) ? j + ATT_NS - 2 : NT - 1) - j;
        if (y >= 4) ATT_WAITBAR(8); else if (y == 3) ATT_WAITBAR(6); else if (y == 2) ATT_WAITBAR(4); else if (y == 1) ATT_WAITBAR(2); else ATT_WAITBAR(0);
        if (j + ATT_NS - 1 < NT) ATT_DMA(j + ATT_NS - 1);
        const int rj = (ut == 2) ? resA + (j >> 2) : resA, kt = (ut == 2) ? (j & 3) : kt_start + j;
        if (rj != res_w || kt > qt || kt < qt - 4) continue;
        LAS const unsigned char* sl = lds + (j % ATT_NS) * ATT_SLOT;
        f32x16 s = f32x16{};
#pragma unroll
        for (int d0 = 0; d0 < 8; ++d0) { const bf16x8 kf = *(LAS const bf16x8*)(sl + 256 * x + 16 * ((2 * d0 + hi) ^ kx)); s = __builtin_amdgcn_mfma_f32_32x32x16_bf16(kf, qf[d0], s, 0, 0, 0); }
        const int dj = 32 * kt - i0 - x;
        float mx = -INFINITY;
#pragma unroll
        for (int r = 0; r < 16; ++r) { const int d = dj + crow(r, hi); s[r] = (d <= 0 && d >= -128) ? s[r] : -INFINITY; mx = fmaxf(mx, s[r]); }
        mx = fmaxf(mx, __shfl_xor(mx, 32));
        const float mnew = fmaxf(mrun, mx), alpha = __builtin_amdgcn_exp2f(mrun - mnew);
        float rs = 0.f;
#pragma unroll
        for (int r = 0; r < 16; ++r) { s[r] = __builtin_amdgcn_exp2f(s[r] - mnew); rs += s[r]; }
        rs += __shfl_xor(rs, 32);
        lrun = lrun * alpha + rs; mrun = mnew;
#pragma unroll
        for (int c = 0; c < 4; ++c)
#pragma unroll
            for (int r = 0; r < 16; ++r) o[c][r] *= alpha;
        bf16x8 pb[2];
#pragma unroll
        for (int jj = 0; jj < 2; ++jj) { u32x4 w; w.x = cvt_pk_bf16(s[8 * jj], s[8 * jj + 1]); w.y = cvt_pk_bf16(s[8 * jj + 2], s[8 * jj + 3]); w.z = cvt_pk_bf16(s[8 * jj + 4], s[8 * jj + 5]); w.w = cvt_pk_bf16(s[8 * jj + 6], s[8 * jj + 7]); pb[jj] = __builtin_bit_cast(bf16x8, w); }
#pragma unroll
        for (int c = 0; c < 4; ++c)
#pragma unroll
            for (int jj = 0; jj < 2; ++jj) { const s16x4 lo = vtr(sl + tra[c][0] + 4096 * jj), hi4 = vtr(sl + tra[c][1] + 4096 * jj);
                const bf16x8 vf = (bf16x8){lo[0], lo[1], lo[2], lo[3], hi4[0], hi4[1], hi4[2], hi4[3]};
                o[c] = __builtin_amdgcn_mfma_f32_32x32x16_bf16(vf, pb[jj], o[c], 0, 0, 0); }
    }
#undef ATT_DMA
    const float inv = 1.0f / lrun;
    const size_t row = rowbase + res_w + (size_t)dil * (i0 + x);
    bf16_t* po = PO + ((size_t)ut * M + row) * 1024 + h * 128 + 4 * hi;
#pragma unroll
    for (int c = 0; c < 4; ++c)
#pragma unroll
        for (int rr = 0; rr < 4; ++rr) { unsigned long long w = (unsigned long long)cvt_pk_bf16(o[c][4 * rr] * inv, o[c][4 * rr + 1] * inv) | ((unsigned long long)cvt_pk_bf16(o[c][4 * rr + 2] * inv, o[c][4 * rr + 3] * inv) << 32);
            *(unsigned long long*)(po + 32 * c + 8 * rr) = w; }
    if (hi == 0) LSE[((size_t)ut * M + row) * 8 + h] = mrun + __builtin_amdgcn_logf(lrun);
    asm volatile("s_waitcnt lgkmcnt(0)\n\ts_barrier" ::: "memory");
}
__device__ __forceinline__ void attn_phase(unsigned char* ws, LAS unsigned char* lds, int nblk, int bid, int wave, int lane) {
    const bf16_t* QKV = (const bf16_t*)(ws + WS_QKV); bf16_t* PO = (bf16_t*)(ws + WS_PO); float* LSE = (float*)(ws + WS_LSE);
    for (int u = bid; u < 3 * 512; u += nblk) attn_unit(QKV, PO, LSE, u >> 9, u & 511, lds, wave, lane);
}
__device__ __forceinline__ void mix_phase(unsigned char* ws, int gt, int ngt) {
    const bf16_t* PO = (const bf16_t*)(ws + WS_PO); const float* LSE = (const float*)(ws + WS_LSE); bf16_t* AH = (bf16_t*)(ws + WS_AH);
    for (int task = gt; task < M * 128; task += ngt) {
        const size_t row = (size_t)(task >> 7); const int h = (task >> 4) & 7, ch = task & 15;
        const float l0 = LSE[row * 8 + h], l1 = LSE[((size_t)M + row) * 8 + h], l2 = LSE[((size_t)2 * M + row) * 8 + h];
        const float mx = fmaxf(l0, fmaxf(l1, l2));
        float w0 = __builtin_amdgcn_exp2f(l0 - mx), w1 = __builtin_amdgcn_exp2f(l1 - mx), w2 = __builtin_amdgcn_exp2f(l2 - mx);
        const float inv = 1.0f / (w0 + w1 + w2); w0 *= inv; w1 *= inv; w2 *= inv;
        f32x4 a0, b0, a1, b1, a2, b2;
        pg8::unpack8(*(const u32x4*)(PO + row * 1024 + h * 128 + ch * 8), a0, b0);
        pg8::unpack8(*(const u32x4*)(PO + ((size_t)M + row) * 1024 + h * 128 + ch * 8), a1, b1);
        pg8::unpack8(*(const u32x4*)(PO + ((size_t)2 * M + row) * 1024 + h * 128 + ch * 8), a2, b2);
        *(u32x4*)(AH + row * 1024 + h * 128 + ch * 8) = pg8::pack8(a0 * w0 + a1 * w1 + a2 * w2, b0 * w0 + b1 * w1 + b2 * w2);
    }
}
__device__ __forceinline__ void conv_phase(const float* __restrict__ cw, unsigned char* ws, int gt, int ngt) {
    const bf16_t* Z = (const bf16_t*)(ws + WS_Z); bf16_t* Bg = (bf16_t*)(ws + WS_BG);
    for (int task = gt; task < (M / 8) * 256; task += ngt) {
        const int ch = task & 255, tb = task >> 8; const int t0 = tb * 8; const int c8 = ch * 8;
        f32x4 w0a = *(const f32x4*)(cw + c8), w0b = *(const f32x4*)(cw + c8 + 4), w1a = *(const f32x4*)(cw + 2048 + c8), w1b = *(const f32x4*)(cw + 2048 + c8 + 4), w2a = *(const f32x4*)(cw + 4096 + c8), w2b = *(const f32x4*)(cw + 4096 + c8 + 4);
        f32x4 zm2a = {0.f, 0.f, 0.f, 0.f}, zm2b = zm2a, zm1a = zm2a, zm1b = zm2a;
        if ((t0 & (SEQ - 1)) != 0) { pg8::unpack8(*(const u32x4*)(Z + (size_t)(t0 - 2) * 2048 + c8), zm2a, zm2b); pg8::unpack8(*(const u32x4*)(Z + (size_t)(t0 - 1) * 2048 + c8), zm1a, zm1b); }
#pragma unroll
        for (int i = 0; i < 8; ++i) { const size_t off = (size_t)(t0 + i) * 2048 + c8;
            f32x4 za, zb, ba, bb; pg8::unpack8(*(const u32x4*)(Z + off), za, zb); pg8::unpack8(*(const u32x4*)(Bg + off), ba, bb);
            const f32x4 ya = w0a * za + w1a * zm1a + w2a * zm2a, yb = w0b * zb + w1b * zm1b + w2b * zm2b;
            *(u32x4*)(Bg + off) = pg8::pack8(ba * ya, bb * yb);
            zm2a = zm1a; zm2b = zm1b; zm1a = za; zm1b = zb; }
    }
}
__global__ void __launch_bounds__(NWAVES * 64, 2) fwd_megakernel(Args args) {
    extern __shared__ __attribute__((aligned(16))) unsigned char lds_raw[];
    cg::grid_group grid = cg::this_grid();
    LAS unsigned char* lds = (LAS unsigned char*)lds_raw;
    const int tid = threadIdx.x, lane = tid & 63, wave = __builtin_amdgcn_readfirstlane(tid >> 6);
    const int G = gridDim.x, bid = blockIdx.x;
    const int gw = bid * NWAVES + wave, ngw = G * NWAVES, gt = bid * (NWAVES * 64) + tid, ngt = G * NWAVES * 64;
    unsigned char* ws = args.ws;
    const float* x = args.in[0];
    float* out = args.out;
    bf16_t* Gt = (bf16_t*)out;
    volatile LAS unsigned* bst = (volatile LAS unsigned*)(lds + LDS_BYTES - 16);
    if (tid < 2) bst[tid] = 0u;
    __syncthreads();
    XcdBarrier bar = xcd_barrier_post((unsigned*)ws + CW_BAR, bst);

    p0_weights(args, ws, (LAS float*)(lds + wave * 16640), gw, ngw, lane);
    { bf16_t* xb = (bf16_t*)(ws + WS_XB);
      for (size_t i = gt; i < (size_t)M * DM / 8; i += ngt) { const f32x4 a = *(const f32x4*)(x + i * 8), b = *(const f32x4*)(x + i * 8 + 4); *(u32x4*)(xb + i * 8) = pg8::pack8(a, b); } }
    grid.sync();
    { pg8::Gemm g{(const bf16_t*)(ws + WS_XB), (const bf16_t*)(ws + WS_WIN), M, INC, DM}; pg8::StaticOrder S; S.init(M, INC, G, bid);
      pg8::EpiInProj E{(bf16_t*)(ws + WS_QKV), (bf16_t*)(ws + WS_Z), (bf16_t*)(ws + WS_BG), Gt, QSCALE};
      pg8::gemm_phase<pg8::EpiInProj, pg8::StaticOrder, true, true>(lds, g, S, E); }
    xcd_barrier(bar);
    attn_phase(ws, lds, G, bid, wave, lane);
    conv_phase(args.in[2], ws, gt, ngt);
    xcd_barrier(bar);
    mix_phase(ws, gt, ngt);
    xcd_barrier(bar);
    p3_weights(args, ws, (LAS float*)(lds + wave * 16640), gw, ngw, lane);
    __syncthreads();
    { pg8::Gemm g{(const bf16_t*)(ws + WS_AH), (const bf16_t*)(ws + WS_WAO), M, DM, AOW}; pg8::StaticOrder S; S.init(M, DM, G, bid);
      pg8::EpiGateMul E{Gt, 4096, (bf16_t*)(ws + WS_T)};
      pg8::gemm_phase<pg8::EpiGateMul, pg8::StaticOrder, true, true>(lds, g, S, E); }
    { pg8::Gemm g{(const bf16_t*)(ws + WS_BG), (const bf16_t*)(ws + WS_WCO), M, DM, DM}; pg8::StaticOrder S; S.init(M, DM, G, bid);
      pg8::EpiGateMulAdd E{Gt + 2048, 4096, (const bf16_t*)(ws + WS_T), (bf16_t*)(ws + WS_MG)};
      pg8::gemm_phase<pg8::EpiGateMulAdd, pg8::StaticOrder, true, true>(lds, g, S, E); }
    xcd_barrier(bar);
    { pg8::Gemm g{(const bf16_t*)(ws + WS_MG), (const bf16_t*)(ws + WS_WOUT), M, DM, DM}; pg8::StaticOrder S; S.init(M, DM, G, bid);
      pg8::EpiResF32 E{x, out, ALPHA};
      pg8::gemm_phase<pg8::EpiResF32, pg8::StaticOrder, true, true>(lds, g, S, E); }
    xcd_barrier(bar);
    ln_rows(out, args.in[6], args.in[7], (bf16_t*)(ws + WS_X1B), gw, ngw, lane);
    xcd_barrier(bar);
    { pg8::Gemm g{(const bf16_t*)(ws + WS_X1B), (const bf16_t*)(ws + WS_WGU), M, 2 * FFN, DM}; pg8::StaticOrder S; S.init(M, 2 * FFN, G, bid);
      pg8::EpiSwiGlu E{(bf16_t*)(ws + WS_H)};
      pg8::gemm_phase<pg8::EpiSwiGlu, pg8::StaticOrder, true, true>(lds, g, S, E); }
    xcd_barrier(bar);
    { pg8::Gemm g{(const bf16_t*)(ws + WS_H), (const bf16_t*)(ws + WS_WDN), M, DM, FFN}; pg8::StaticOrder S; S.init(M, DM, G, bid);
      pg8::EpiResF32 E{out, out, ALPHA};
      pg8::gemm_phase<pg8::EpiResF32, pg8::StaticOrder, true, true>(lds, g, S, E); }
    xcd_barrier(bar);
    ln_rows(out, args.in[11], args.in[12], nullptr, gw, ngw, lane);
}

extern "C" void kernel_launch(void* const* d_in, const int* in_sizes, int n_in, void* d_out, int out_size, void* d_ws, size_t ws_size, hipStream_t stream) {
    static int grid = 0;
    if (grid == 0) {
        if (n_in != 13 || out_size != M * DM || ws_size < WS_NEED) { fprintf(stderr, "kernel_launch: unexpected problem (n_in %d, out %d, ws %zu)\n", n_in, out_size, ws_size); grid = -1; return; }
        int dev = 0, cus = 0, per_cu = 0;
        (void)hipGetDevice(&dev); (void)hipDeviceGetAttribute(&cus, hipDeviceAttributeMultiprocessorCount, dev);
        (void)hipFuncSetAttribute((const void*)fwd_megakernel, hipFuncAttributeMaxDynamicSharedMemorySize, LDS_BYTES);
        (void)hipOccupancyMaxActiveBlocksPerMultiprocessor(&per_cu, (const void*)fwd_megakernel, NWAVES * 64, LDS_BYTES);
        if (per_cu < 1) per_cu = 1;
        if (cus < 1) cus = 256;
        grid = cus;
        (void)hipGetLastError();
    }
    if (grid < 0) return;
    (void)hipMemsetAsync(d_ws, 0, CTL_ZERO_BYTES, stream);
    Args a{};
    for (int i = 0; i < 13; ++i) a.in[i] = (const float*)d_in[i];
    a.out = (float*)d_out; a.ws = (unsigned char*)d_ws;
    void* kargs[] = {&a};
    hipError_t e = hipLaunchCooperativeKernel((const void*)fwd_megakernel, dim3(grid), dim3(NWAVES * 64), kargs, LDS_BYTES, stream);
    if (e != hipSuccess) fprintf(stderr, "cooperative launch failed: %s (grid %d)\n", hipGetErrorString(e), grid);
}
```
